# Optimizing an MI355X kernel written in HIP

```python
import math
import jax
import jax.numpy as jnp
from jax import lax
import numpy as np

D_MODEL = 1024
BATCH = 32
SEQ = 2048
DEPTH = 4

CTX_LEN = 256
GRID_W = 64
EPS = 1e-6
NEG_INF = -1e30
F32 = jnp.float32

MIX_WIDTH = D_MODEL
RET_HEADS = 4
RET_V = MIX_WIDTH // 4
RET_DV = RET_V // RET_HEADS
RET_DK = RET_DV // 2
RET_QK = RET_HEADS * RET_DK
RET_CHUNK = 128
RET_ROT_BASE = 10000.0
HY_CH = MIX_WIDTH // 4
HY_EMB = 33
HY_BANDS = (HY_EMB - 1) // 2
HY_ORDER = 64
HY_INNER = 2
HY_FAST_DECAY = 0.3
HY_SLOW_DECAY = 1.5
HY_TARGET = 1e-2
ATT_HEADS = 8
ATT_KV_HEADS = 2
ATT_GROUP = ATT_HEADS // ATT_KV_HEADS
ATT_Q = MIX_WIDTH - RET_V - HY_CH
ATT_HD = ATT_Q // ATT_HEADS
ATT_KV = ATT_KV_HEADS * ATT_HD
WINDOW = 128
ATT_BLOCK = 128
ATT_HALO = -(-WINDOW // ATT_BLOCK)
ROPE_BASE = 10000.0
D_FF = 4 * D_MODEL

SPLIT_SIZES = (RET_QK, RET_QK, RET_V, RET_V, 3 * HY_CH, ATT_Q, ATT_KV, ATT_KV)
D_IN = 2 * RET_QK + 2 * RET_V + 3 * HY_CH + ATT_Q + 2 * ATT_KV

kernel_name = 'hybrid_retention_hyena_swa_prefix_dit'


def rms_norm(x, g=None):
    xf = x.astype(F32)
    y = xf * lax.rsqrt(jnp.mean(xf * xf, axis=-1, keepdims=True) + EPS)
    if g is not None:
        y = y * g.astype(F32)
    return y.astype(x.dtype)


def modulate(h, shift, scale):
    return h * (1.0 + scale) + shift


def rotate_half(x):
    x1, x2 = jnp.split(x, 2, axis=-1)
    return jnp.concatenate([-x2, x1], axis=-1)


def rotary_table(pos_f, inv_freq):
    ang = pos_f[:, None] * inv_freq[None, :]
    ang = jnp.concatenate([ang, ang], axis=-1)
    return jnp.cos(ang), jnp.sin(ang)


def apply_rotary(x, cos, sin):
    cos = cos[None, :, None, :].astype(x.dtype)
    sin = sin[None, :, None, :].astype(x.dtype)
    return x * cos + rotate_half(x) * sin


def apply_axial(x, tabs):
    cos_r, sin_r, cos_c, sin_c = tabs
    half = x.shape[-1] // 2
    return jnp.concatenate([apply_rotary(x[..., :half], cos_r, sin_r),
                            apply_rotary(x[..., half:], cos_c, sin_c)], axis=-1)


def split_proj(p):
    out, o = [], 0
    for s in SPLIT_SIZES:
        out.append(p[..., o:o + s])
        o += s
    return out


def sq_relu_mlp(h, w1, w2):
    return jnp.square(jax.nn.relu(h @ w1)) @ w2


def retention_chunkwise(q, k, v, log_g, s0):
    B, L, H, DK = q.shape
    DV = v.shape[-1]
    C = RET_CHUNK
    N = L // C
    qc = q.reshape(B, N, C, H, DK)
    kc = k.reshape(B, N, C, H, DK)
    vc = v.reshape(B, N, C, H, DV)
    idx = jnp.arange(C, dtype=F32)
    diff = idx[:, None] - idx[None, :]
    dmask = jnp.where(diff >= 0, jnp.exp(log_g[:, None, None] * jnp.maximum(diff, 0.0)[None]), 0.0)
    scores = jnp.einsum('bnihd,bnjhd->bnhij', qc, kc) * dmask
    o_inner = jnp.einsum('bnhij,bnjhe->bnihe', scores, vc)
    k_dec = jnp.exp(log_g[None, :] * (C - 1 - idx)[:, None])
    kv = jnp.einsum('bnjhd,jh,bnjhe->nbhde', kc, k_dec, vc)
    chunk_dec = jnp.exp(log_g * C)[None, :, None, None]

    def step(s, kv_n):
        return chunk_dec * s + kv_n, s

    _, s_start = lax.scan(step, s0, kv)
    q_dec = jnp.exp(log_g[None, :] * (idx + 1.0)[:, None])
    o_cross = jnp.einsum('bnihd,ih,nbhde->bnihe', qc, q_dec, s_start)
    return (o_inner + o_cross).reshape(B, L, H, DV)


def retention_bidir(q, k, v, log_f, log_b, s_f, s_b):
    fwd = retention_chunkwise(q, k, v, log_f, s_f)
    bwd = retention_chunkwise(jnp.flip(q, 1), jnp.flip(k, 1), jnp.flip(v, 1), log_b, s_b)
    return fwd + jnp.flip(bwd, 1)


def retention_ctx_states(k, v, log_f, log_b):
    m = jnp.arange(k.shape[1], dtype=F32)
    w_f = jnp.exp(log_f[None, :] * (k.shape[1] - 1.0 - m)[:, None])
    w_b = jnp.exp(log_b[None, :] * m[:, None])
    s_f = jnp.einsum('bmhd,mh,bmhe->bhde', k, w_f, v)
    s_b = jnp.einsum('bmhd,mh,bmhe->bhde', k, w_b, v)
    return s_f, s_b


def short_conv(u, w, b):
    up = jnp.pad(u, ((0, 0), (1, 1), (0, 0)))
    return up[:, :-2] * w[0] + up[:, 1:-1] * w[1] + up[:, 2:] * w[2] + b


def hyena_filters(L, w1, b1, w2, b2, w3, freq):
    t = jnp.linspace(0.0, 1.0, L, dtype=F32)[:, None]
    w = 2.0 * math.pi * jnp.arange(L, dtype=F32) / L
    bands = jnp.linspace(1e-4, HY_BANDS - 1, HY_BANDS, dtype=F32)
    ang = w[:, None] * bands[None, :]
    z = jnp.concatenate([t, jnp.cos(ang), -jnp.sin(ang)], axis=-1)
    fr = freq.astype(F32)
    h = jnp.sin(fr * (z @ w1.astype(F32) + b1.astype(F32)))
    for j in range(HY_INNER):
        h = jnp.sin(fr * (h @ w2[j].astype(F32) + b2[j].astype(F32)))
    h = h @ w3.astype(F32)
    max_decay = math.log(HY_TARGET) / HY_FAST_DECAY
    min_decay = math.log(HY_TARGET) / HY_SLOW_DECAY
    deltas = jnp.linspace(min_decay, max_decay, HY_CH, dtype=F32)
    decay = jnp.exp(-t * jnp.abs(deltas)[None, :])
    h = h.reshape(L, 2, HY_CH) * decay[:, None, :]
    return h[:, 0], h[:, 1]


def long_conv(z, h_f, h_b):
    L = z.shape[1]
    n = 2 * L
    filt = jnp.concatenate([h_f, jnp.zeros((1, h_f.shape[1]), F32), h_b[1:][::-1]], axis=0)
    zf = jnp.fft.rfft(z.astype(F32), n=n, axis=1)
    hf = jnp.fft.rfft(filt, n=n, axis=0)
    y = jnp.fft.irfft(zf * hf[None], n=n, axis=1)[:, :L]
    return y.astype(z.dtype)


def hyena_mix(u, short_w, short_b, filt, hy_bias):
    u = short_conv(u, short_w, short_b)
    v, x1, x0 = jnp.split(u, 3, axis=-1)
    h_f, h_b = hyena_filters(u.shape[1], *filt)
    z = v * x1
    y = long_conv(z, h_f, h_b) + z * hy_bias
    return y * x0


def sink_attend(q, k, v, bias, sink):
    s = jnp.einsum('bqhgd,bkhd->bhgqk', q, k).astype(F32) * (ATT_HD ** -0.5) + bias
    sk = sink[None, :, :, None, None]
    m = jnp.maximum(jnp.max(s, axis=-1, keepdims=True), sk)
    p = jnp.exp(s - m)
    den = jnp.sum(p, axis=-1, keepdims=True) + jnp.exp(sk - m)
    return jnp.einsum('bhgqk,bkhd->bqhgd', (p / den).astype(v.dtype), v)


def window_attention(q, k, v, kc, vc, sink):
    B, L = q.shape[0], q.shape[1]
    nb = L // ATT_BLOCK
    nband = 2 * ATT_HALO + 1
    pad = ATT_HALO * ATT_BLOCK
    qb = jnp.moveaxis(q.reshape(B, nb, ATT_BLOCK, ATT_KV_HEADS, ATT_GROUP, ATT_HD), 1, 0)

    def band(t):
        tp = jnp.pad(t, ((0, 0), (pad, pad), (0, 0), (0, 0)))
        blocks = [tp[:, s * ATT_BLOCK: s * ATT_BLOCK + L].reshape(B, nb, ATT_BLOCK, ATT_KV_HEADS, ATT_HD)
                  for s in range(nband)]
        return jnp.moveaxis(jnp.concatenate(blocks, axis=2), 1, 0)

    kb, vb = band(k), band(v)
    ii = jnp.arange(ATT_BLOCK)[:, None]
    jj = jnp.arange(nband * ATT_BLOCK)[None, :]
    in_window = jnp.abs(jj - pad - ii) <= WINDOW
    key_pos = jnp.arange(nb)[:, None] * ATT_BLOCK - pad + jnp.arange(nband * ATT_BLOCK)[None, :]
    in_range = (key_pos >= 0) & (key_pos < L)
    band_bias = jnp.where(in_window[None] & in_range[:, None, :], 0.0, NEG_INF).astype(F32)
    ctx_bias = jnp.zeros((ATT_BLOCK, kc.shape[1]), F32)

    def one_block(args):
        qn, kn, vn, bn = args
        return sink_attend(qn, jnp.concatenate([kn, kc], axis=1), jnp.concatenate([vn, vc], axis=1),
                           jnp.concatenate([bn, ctx_bias], axis=-1), sink)

    ob = lax.map(one_block, (qb, kb, vb, band_bias))
    return jnp.moveaxis(ob, 0, 1).reshape(B, L, ATT_Q)


def trunk_layer(x, xc, sc, scc, axial_tabs, ret_tabs, lp, last):
    (w_ada, b_ada, g_pre_mix, g_post_mix, g_pre_mlp, g_post_mlp, w_in, dec_f, dec_b,
     short_w, short_b, f_w1, f_b1, f_w2, f_b2, f_w3, f_freq, hy_bias, attn_sink,
     g_ret, g_hy, g_att, w_out, w_ff1, w_ff2) = lp
    B, L, _ = x.shape
    Lc = xc.shape[1]
    sh_a, sc_a, gt_a, sh_m, sc_m, gt_m = jnp.split((sc @ w_ada + b_ada)[:, None, :], 6, axis=-1)
    csh_a, csc_a, cgt_a, csh_m, csc_m, cgt_m = jnp.split((scc @ w_ada + b_ada)[None, None, :], 6, axis=-1)
    log_f = jnp.log1p(-jnp.exp(dec_f.astype(F32)))
    log_b = jnp.log1p(-jnp.exp(dec_b.astype(F32)))
    sink = attn_sink.astype(F32).reshape(ATT_KV_HEADS, ATT_GROUP)
    filt = (f_w1, f_b1, f_w2, f_b2, f_w3, f_freq)
    k_scale = RET_DK ** -0.5

    px = modulate(rms_norm(x, g_pre_mix), sh_a, sc_a) @ w_in
    pc = modulate(rms_norm(xc, g_pre_mix), csh_a, csc_a) @ w_in
    rq, rk, rv, rg, hy, aq, ak, av = split_proj(px)
    crq, crk, crv, crg, chy, caq, cak, cav = split_proj(pc)

    crk = crk.reshape(B, Lc, RET_HEADS, RET_DK).astype(F32) * k_scale
    crv = crv.reshape(B, Lc, RET_HEADS, RET_DV).astype(F32)
    s_f, s_b = retention_ctx_states(crk, crv, log_f, log_b)
    rq = apply_rotary(rq.reshape(B, L, RET_HEADS, RET_DK), *ret_tabs).astype(F32)
    rk = apply_rotary(rk.reshape(B, L, RET_HEADS, RET_DK), *ret_tabs).astype(F32) * k_scale
    rv = rv.reshape(B, L, RET_HEADS, RET_DV).astype(F32)
    ret = retention_bidir(rq, rk, rv, log_f, log_b, s_f, s_b)
    ret = rms_norm(ret).reshape(B, L, RET_V).astype(x.dtype) * jax.nn.silu(rg)

    hyo = hyena_mix(hy, short_w, short_b, filt, hy_bias)

    aq = apply_axial(aq.reshape(B, L, ATT_HEADS, ATT_HD), axial_tabs)
    ak = apply_axial(ak.reshape(B, L, ATT_KV_HEADS, ATT_HD), axial_tabs)
    av = av.reshape(B, L, ATT_KV_HEADS, ATT_HD)
    cak = cak.reshape(B, Lc, ATT_KV_HEADS, ATT_HD)
    cav = cav.reshape(B, Lc, ATT_KV_HEADS, ATT_HD)
    att = window_attention(aq, ak, av, cak, cav, sink)

    mix = jnp.concatenate([rms_norm(ret, g_ret), rms_norm(hyo, g_hy), rms_norm(att, g_att)], axis=-1) @ w_out
    x = x + gt_a * rms_norm(mix, g_post_mix)

    if not last:
        zeros = jnp.zeros((B, RET_HEADS, RET_DK, RET_DV), F32)
        crq = crq.reshape(B, Lc, RET_HEADS, RET_DK).astype(F32)
        cret = retention_bidir(crq, crk, crv, log_f, log_b, zeros, zeros)
        cret = rms_norm(cret).reshape(B, Lc, RET_V).astype(xc.dtype) * jax.nn.silu(crg)
        chyo = hyena_mix(chy, short_w, short_b, filt, hy_bias)
        catt = sink_attend(caq.reshape(B, Lc, ATT_KV_HEADS, ATT_GROUP, ATT_HD), cak, cav, 0.0, sink)
        catt = catt.reshape(B, Lc, ATT_Q)
        cmix = jnp.concatenate([rms_norm(cret, g_ret), rms_norm(chyo, g_hy), rms_norm(catt, g_att)], axis=-1) @ w_out
        xc = xc + cgt_a * rms_norm(cmix, g_post_mix)

    hm = sq_relu_mlp(modulate(rms_norm(x, g_pre_mlp), sh_m, sc_m), w_ff1, w_ff2)
    x = x + gt_m * rms_norm(hm, g_post_mlp)
    if not last:
        hcm = sq_relu_mlp(modulate(rms_norm(xc, g_pre_mlp), csh_m, csc_m), w_ff1, w_ff2)
        xc = xc + cgt_m * rms_norm(hcm, g_post_mlp)
    return x, xc


def setup_inputs(seed: int = 0) -> dict:
    key = jax.random.key(seed)
    ks = iter(jax.random.split(key, 32))

    def nrm(shape, scale):
        return scale * jax.random.normal(next(ks), shape, F32)

    ret_base = (-(5.0 + jnp.arange(RET_HEADS, dtype=F32)) * math.log(2.0))[None, :]
    return {
        'x': nrm((BATCH, SEQ, D_MODEL), 1.0),
        'c': nrm((BATCH, D_MODEL), 1.0),
        'ctx': nrm((BATCH, CTX_LEN, D_MODEL), 1.0),
        'c_ctx': nrm((D_MODEL,), 1.0),
        'w_ada': nrm((DEPTH, D_MODEL, 6 * D_MODEL), 0.5 * D_MODEL ** -0.5),
        'b_ada': nrm((DEPTH, 6 * D_MODEL), 0.02),
        'g_pre_mix': 1.0 + nrm((DEPTH, D_MODEL), 0.05),
        'g_post_mix': 1.0 + nrm((DEPTH, D_MODEL), 0.05),
        'g_pre_mlp': 1.0 + nrm((DEPTH, D_MODEL), 0.05),
        'g_post_mlp': 1.0 + nrm((DEPTH, D_MODEL), 0.05),
        'w_in': nrm((DEPTH, D_MODEL, D_IN), D_MODEL ** -0.5),
        'ret_decay_fwd': ret_base + nrm((DEPTH, RET_HEADS), 0.1),
        'ret_decay_bwd': ret_base + nrm((DEPTH, RET_HEADS), 0.1),
        'hy_short_w': nrm((DEPTH, 3, 3 * HY_CH), 3.0 ** -0.5),
        'hy_short_b': nrm((DEPTH, 3 * HY_CH), 0.02),
        'hy_f_w1': nrm((DEPTH, HY_EMB, HY_ORDER), HY_EMB ** -0.5),
        'hy_f_b1': nrm((DEPTH, HY_ORDER), 0.1),
        'hy_f_w2': nrm((DEPTH, HY_INNER, HY_ORDER, HY_ORDER), HY_ORDER ** -0.5),
        'hy_f_b2': nrm((DEPTH, HY_INNER, HY_ORDER), 0.1),
        'hy_f_w3': nrm((DEPTH, HY_ORDER, 2 * HY_CH), HY_ORDER ** -0.5),
        'hy_f_freq': 1.0 + nrm((DEPTH, HY_ORDER), 0.05),
        'hy_bias': nrm((DEPTH, HY_CH), 0.5),
        'attn_sink': nrm((DEPTH, ATT_HEADS), 0.5),
        'g_ret': 1.0 + nrm((DEPTH, RET_V), 0.05),
        'g_hy': 1.0 + nrm((DEPTH, HY_CH), 0.05),
        'g_att': 1.0 + nrm((DEPTH, ATT_Q), 0.05),
        'w_out': nrm((DEPTH, MIX_WIDTH, D_MODEL), MIX_WIDTH ** -0.5),
        'w_ff1': nrm((DEPTH, D_MODEL, D_FF), D_MODEL ** -0.5),
        'w_ff2': nrm((DEPTH, D_FF, D_MODEL), D_FF ** -0.5),
    }


def reference(x, c, ctx, c_ctx, w_ada, b_ada, g_pre_mix, g_post_mix, g_pre_mlp, g_post_mlp,
              w_in, ret_decay_fwd, ret_decay_bwd, hy_short_w, hy_short_b, hy_f_w1, hy_f_b1,
              hy_f_w2, hy_f_b2, hy_f_w3, hy_f_freq, hy_bias, attn_sink, g_ret, g_hy, g_att,
              w_out, w_ff1, w_ff2):
    n_tok = x.shape[1]
    ROWS = n_tok // GRID_W
    pos = jnp.arange(ROWS * GRID_W)
    row = (pos // GRID_W).astype(F32)
    col = (pos % GRID_W).astype(F32)
    half = ATT_HD // 2
    inv_ax = ROPE_BASE ** (-jnp.arange(0, half, 2, dtype=F32) / half)
    cos_r, sin_r = rotary_table(row, inv_ax)
    cos_c, sin_c = rotary_table(col, inv_ax)
    axial_tabs = (cos_r, sin_r, cos_c, sin_c)
    inv_ret = 1.0 / (RET_ROT_BASE ** jnp.linspace(0.0, 1.0, RET_DK // 2, dtype=F32))
    ret_tabs = rotary_table(pos.astype(F32), inv_ret)

    sc = jax.nn.silu(c)
    scc = jax.nn.silu(c_ctx)
    xc = ctx
    for i in range(DEPTH):
        lp = (w_ada[i], b_ada[i], g_pre_mix[i], g_post_mix[i], g_pre_mlp[i], g_post_mlp[i], w_in[i],
              ret_decay_fwd[i], ret_decay_bwd[i], hy_short_w[i], hy_short_b[i], hy_f_w1[i], hy_f_b1[i],
              hy_f_w2[i], hy_f_b2[i], hy_f_w3[i], hy_f_freq[i], hy_bias[i], attn_sink[i],
              g_ret[i], g_hy[i], g_att[i], w_out[i], w_ff1[i], w_ff2[i])
        x, xc = trunk_layer(x, xc, sc, scc, axial_tabs, ret_tabs, lp, i == DEPTH - 1)
    return x
```

```cpp
#include <hip/hip_runtime.h>
#include <hip/hip_cooperative_groups.h>
#include <cstdio>
#include <cstdint>
namespace cg = cooperative_groups;
#include <hip/hip_runtime.h>
namespace pg8 {
#define PG8_LAS __attribute__((address_space(3)))
typedef unsigned short bf16_t;
typedef short bf16x8 __attribute__((ext_vector_type(8)));
typedef float f32x4 __attribute__((ext_vector_type(4)));
typedef unsigned u32x4 __attribute__((ext_vector_type(4)));
constexpr int BM = 256, BK = 64, HALF = 128, HTB = HALF * BK * 2  , STAGE_BYTES = 8 * HTB, NXCD = 8, WGM = 8;

__host__ __device__ __forceinline__ int lds_byte(int r, int c) { const int st = (r >> 4) * 2 + (c >> 5), rr = r & 15, cc = c & 31, ob = rr * 64 + cc * 2; return st * 1024 + (ob ^ (((ob >> 9) & 1) << 5)); }
__host__ __device__ __forceinline__ void stage_rc(int b, int& R, int& C) { const int st = b / 1024, sb = b % 1024, swz = sb ^ (((sb >> 9) & 1) << 5); R = (st >> 1) * 16 + swz / 64; C = (st & 1) * 32 + (swz % 64) / 2; }
__host__ __device__ __forceinline__ int perm32(int rho) { const int n = rho >> 4, i = rho & 15; return 8 * (i >> 2) + 4 * n + (i & 3); }

struct Unit { int pm, pn; };
struct Gemm { const bf16_t* A; const bf16_t* Bt; int M, N, K; };

struct StaticOrder {
    int nM, nN, nwg, G, c;
    __host__ __device__ void init(int M, int N, int G_, int c_) { nM = M / BM; nN = N / BM; nwg = nM * nN; G = G_; c = c_; }
    __host__ __device__ bool next(int i, Unit& u) const {
        const long L = (long)i * G + c; if (L >= nwg) return false;
        int wgid = (int)L; { const int q = nwg / NXCD, r = nwg % NXCD, xcd = wgid % NXCD, off = wgid / NXCD; wgid = (xcd < r ? xcd * (q + 1) : r * (q + 1) + (xcd - r) * q) + off; }
        const int nig = WGM * nN, gid = wgid / nig, fm = gid * WGM, gsz = (nM - fm) < WGM ? (nM - fm) : WGM;
        u.pm = fm + ((wgid % nig) % gsz); u.pn = (wgid % nig) / gsz; return true;
    }
    __device__ __forceinline__ void a_ready(const Unit&) const {}
    __device__ __forceinline__ void done(const Unit&) const {}
};

struct RevOrder : StaticOrder {
    __host__ __device__ bool next(int i, Unit& u) const { if (!StaticOrder::next(i, u)) return false; u.pm = nM - 1 - u.pm; return true; }
};
__device__ __forceinline__ unsigned cvt_pk_bf16(float lo, float hi) { unsigned r; asm volatile("v_cvt_pk_bf16_f32 %0, %1, %2" : "=v"(r) : "v"(lo), "v"(hi)); return r; }
typedef unsigned u32x2 __attribute__((ext_vector_type(2)));

template <int ACT  > struct EpiBf16 {
    static constexpr bool PERM = true, AFTER_DRAIN = false;
    bf16_t* O; int ldc;
    __device__ __forceinline__ void operator()(const f32x4 (&acc)[2][2][4][2], const Unit& u, int wr, int wc, int fr, int fq) const {
        const int row0 = u.pm * BM + wr * 64 + fr; const int col0 = u.pn * BM + wc * 32 + 8 * fq;
#pragma unroll
        for (int ai = 0; ai < 2; ++ai)
#pragma unroll
            for (int m = 0; m < 4; ++m) { bf16_t* rowp = O + (size_t)(row0 + ai * HALF + m * 16) * ldc + col0;
#pragma unroll
                for (int bj = 0; bj < 2; ++bj) { f32x4 v0 = acc[ai][bj][m][0], v1 = acc[ai][bj][m][1];
                    if (ACT == 1) {
#pragma unroll
                        for (int j = 0; j < 4; ++j) { const float a = fmaxf(v0[j], 0.f), b = fmaxf(v1[j], 0.f); v0[j] = a * a; v1[j] = b * b; } }
                    u32x4 w; w.x = cvt_pk_bf16(v0[0], v0[1]); w.y = cvt_pk_bf16(v0[2], v0[3]); w.z = cvt_pk_bf16(v1[0], v1[1]); w.w = cvt_pk_bf16(v1[2], v1[3]);
                    *(u32x4*)(rowp + bj * HALF) = w; } }
    }
};

struct EpiWin {
    static constexpr bool PERM = false, AFTER_DRAIN = false;
    bf16_t* P; const float* rot_ret; const float* rot_ax;
    __device__ __forceinline__ void operator()(const f32x4 (&acc)[2][2][4][2], const Unit& u, int wr, int wc, int fr, int fq) const {
        const int row0 = u.pm * BM + wr * 64 + fr; const bool latent = (u.pm < 256); const int pn = u.pn;
#pragma unroll
        for (int ai = 0; ai < 2; ++ai)
#pragma unroll
            for (int m = 0; m < 4; ++m) { const int row = row0 + ai * HALF + m * 16; const int pos = row & 2047;
                bf16_t* rowp = P + (size_t)row * 2304 + pn * BM + wc * 32 + 4 * fq;
#pragma unroll
                for (int bj = 0; bj < 2; ++bj) { f32x4 v0 = acc[ai][bj][m][0], v1 = acc[ai][bj][m][1];
                    int mode = 0; float post = 1.f; const float* tab = rot_ret;
                    if (pn == 0) { mode = latent ? 1 : 0; tab = rot_ret + pos * 32 + 4 * fq; if (bj == 1) post = 0.17677669529663687f; }
                    else if (pn == 2) mode = 2;
                    else if (pn == 6 || pn == 7) { mode = latent ? 1 : 0; tab = rot_ax + pos * 64 + (wc & 1) * 32 + 4 * fq; post = 0.125f * 1.4426950408889634f; }
                    else if (pn == 8 && bj == 0) { mode = latent ? 1 : 0; tab = rot_ax + pos * 64 + (wc & 1) * 32 + 4 * fq; }
                    if (mode == 1) { const f32x4 c = *(const f32x4*)tab, s = *(const f32x4*)(tab + 16);
                        const f32x4 o0 = v0 * c - v1 * s, o1 = v1 * c + v0 * s; v0 = o0; v1 = o1; }
                    if (mode == 2) {
#pragma unroll
                        for (int j = 0; j < 4; ++j) { v0[j] = v0[j] / (1.f + __expf(-v0[j])); v1[j] = v1[j] / (1.f + __expf(-v1[j])); } }
                    v0 = v0 * post; v1 = v1 * post;
                    u32x2 w0, w1; w0.x = cvt_pk_bf16(v0[0], v0[1]); w0.y = cvt_pk_bf16(v0[2], v0[3]); w1.x = cvt_pk_bf16(v1[0], v1[1]); w1.y = cvt_pk_bf16(v1[2], v1[3]);
                    *(u32x2*)(rowp + bj * HALF) = w0; *(u32x2*)(rowp + bj * HALF + 16) = w1; } }
    }
};

template <class Epi, class Sched, bool ALIGN_EPI = false, bool SP2 = false>
__device__ __forceinline__ void gemm_phase(PG8_LAS unsigned char* lds, const Gemm g, const Sched& S, const Epi& E) {
    int tid_ = threadIdx.x; asm volatile("" : "+v"(tid_));
    const int tid = tid_, wid = __builtin_amdgcn_readfirstlane(tid >> 6), lane = tid & 63, wr = wid >> 2, wc = wid & 3, fr = lane & 15, fq = lane >> 4;
    const int K = g.K, nt = K / BK;
    unsigned voffA[2], voffB[2];
#pragma unroll
    for (int i = 0; i < 2; ++i) { int R, C; stage_rc(tid * 16 + i * 8192, R, C); const int Rb = Epi::PERM ? ((R & ~31) + perm32(R & 31)) : R;
        voffA[i] = (unsigned)(R * K + C) * 2u; voffB[i] = (unsigned)(Rb * K + C) * 2u; }
    const size_t kstep = (size_t)(BK * 2);
    const size_t hstep = (size_t)HALF * K * 2;
    const size_t tstep = 2 * hstep;
    const unsigned ldsw = (unsigned)wid * 1024u;
    const int aoff = lds_byte(wr * 64 + fr, fq * 8), boff = lds_byte(wc * 32 + fr, fq * 8);
#define PG8_SA(b, h) (((b) * 2 + (h)) * HTB)
#define PG8_SB(b, h) ((4 + (b) * 2 + (h)) * HTB)
#define PG8_STAGE(bufoff, gbase, voff) do { _Pragma("unroll") for (int _i = 0; _i < 2; ++_i) \
        __builtin_amdgcn_global_load_lds((const unsigned*)((const char*)(gbase) + (voff)[_i]), (PG8_LAS unsigned*)(lds + (bufoff) + ldsw + _i * 8192), 16, 0, 0); } while (0)
#define PG8_LDA(dst, b, h) do { _Pragma("unroll") for (int m = 0; m < 4; ++m) _Pragma("unroll") for (int k = 0; k < 2; ++k) dst[m][k] = *(const PG8_LAS bf16x8*)(lds + PG8_SA(b, h) + aoff + m * 2048 + k * 1024); } while (0)
#define PG8_LDB(dst, b, h) do { _Pragma("unroll") for (int n = 0; n < 2; ++n) _Pragma("unroll") for (int k = 0; k < 2; ++k) dst[n][k] = *(const PG8_LAS bf16x8*)(lds + PG8_SB(b, h) + boff + n * 2048 + k * 1024); } while (0)
#define PG8_MMA(ai, bj, At, Bt) do { __builtin_amdgcn_s_setprio(1); _Pragma("unroll") for (int m = 0; m < 4; ++m) _Pragma("unroll") for (int n = 0; n < 2; ++n) _Pragma("unroll") for (int k = 0; k < 2; ++k) \
        acc[ai][bj][m][n] = __builtin_amdgcn_mfma_f32_16x16x32_bf16(Bt[n][k], At[m][k], acc[ai][bj][m][n], 0, 0, 0); __builtin_amdgcn_s_setprio(0); } while (0)
#define PG8_WAIT_V(n) asm volatile("s_waitcnt vmcnt(" #n ")" ::: "memory")
#define PG8_WAIT_L(n) asm volatile("s_waitcnt lgkmcnt(" #n ")" ::: "memory")
#define PG8_BAR __builtin_amdgcn_s_barrier()
#define PG8_SCHED __builtin_amdgcn_sched_barrier(0)
    Unit cur, nxt; int ui = 0;
    if (!S.next(0, cur)) return;
    f32x4 acc[2][2][4][2];
#pragma unroll
    for (int a = 0; a < 2; ++a)
#pragma unroll
        for (int b = 0; b < 2; ++b)
#pragma unroll
            for (int m = 0; m < 4; ++m)
#pragma unroll
                for (int n = 0; n < 2; ++n) acc[a][b][m][n] = (f32x4){0.f, 0.f, 0.f, 0.f};
    bf16x8 At[4][2], B0[2][2], B1[2][2];
    const char* cA = (const char*)g.A + (size_t)cur.pm * tstep; const char* cB = (const char*)g.Bt + (size_t)cur.pn * tstep;
    S.a_ready(cur);
    if constexpr (SP2) {
        PG8_STAGE(PG8_SB(0, 0), cB, voffB); PG8_STAGE(PG8_SB(0, 1), cB + hstep, voffB); PG8_STAGE(PG8_SA(0, 0), cA, voffA); PG8_STAGE(PG8_SA(0, 1), cA + hstep, voffA);
        if (wr == 1) PG8_BAR;
        PG8_WAIT_V(2); PG8_BAR;
        PG8_STAGE(PG8_SB(1, 0), cB + kstep, voffB); PG8_STAGE(PG8_SA(1, 0), cA + kstep, voffA); PG8_STAGE(PG8_SB(1, 1), cB + hstep + kstep, voffB);
        PG8_WAIT_V(6); PG8_BAR;
    } else {
        PG8_STAGE(PG8_SB(0, 0), cB, voffB); PG8_STAGE(PG8_SA(0, 0), cA, voffA); PG8_STAGE(PG8_SB(0, 1), cB + hstep, voffB); PG8_STAGE(PG8_SA(0, 1), cA + hstep, voffA);
        if (wr == 1) PG8_BAR;
        PG8_WAIT_V(4); PG8_BAR;
        PG8_STAGE(PG8_SB(1, 0), cB + kstep, voffB); PG8_STAGE(PG8_SA(1, 0), cA + kstep, voffA); PG8_STAGE(PG8_SB(1, 1), cB + hstep + kstep, voffB);
        PG8_WAIT_V(6); PG8_BAR;
    }
    for (;;) {
        const bool has_next = S.next(ui + 1, nxt);
        const char* nA = has_next ? (const char*)g.A + (size_t)nxt.pm * tstep : cA; const char* nB = has_next ? (const char*)g.Bt + (size_t)nxt.pn * tstep : cB;
        for (int t = 0; t < nt; t += 2) {
            const bool last = (t == nt - 2);
            const char* a1 = cA + (size_t)(t + 1) * kstep;
            const char* a2 = last ? nA : cA + (size_t)(t + 2) * kstep; const char* b2 = last ? nB : cB + (size_t)(t + 2) * kstep;
            const char* a3 = a2 + kstep; const char* b3 = b2 + kstep;
            if (last && has_next) S.a_ready(nxt);
            if constexpr (SP2) {
            PG8_LDB(B0, 0, 0); PG8_LDB(B1, 0, 1); PG8_SCHED; PG8_LDA(At, 0, 0); PG8_STAGE(PG8_SA(1, 1), a1 + hstep, voffA);
            PG8_WAIT_V(8); PG8_WAIT_L(0); PG8_BAR; PG8_MMA(0, 0, At, B0); PG8_MMA(0, 1, At, B1); PG8_BAR; PG8_SCHED;
            PG8_LDA(At, 0, 1); PG8_STAGE(PG8_SB(0, 0), b2, voffB); PG8_STAGE(PG8_SB(0, 1), b2 + hstep, voffB); PG8_STAGE(PG8_SA(0, 0), a2, voffA);
            PG8_WAIT_V(8); PG8_WAIT_L(0); PG8_BAR; PG8_MMA(1, 0, At, B0); PG8_MMA(1, 1, At, B1); PG8_BAR; PG8_SCHED;
            PG8_LDB(B0, 1, 0); PG8_LDB(B1, 1, 1); PG8_SCHED; PG8_LDA(At, 1, 0); PG8_STAGE(PG8_SA(0, 1), a2 + hstep, voffA);
            PG8_WAIT_V(8); PG8_WAIT_L(0); PG8_BAR; PG8_MMA(0, 0, At, B0); PG8_MMA(0, 1, At, B1); PG8_BAR; PG8_SCHED;
            PG8_LDA(At, 1, 1); PG8_STAGE(PG8_SB(1, 0), b3, voffB); PG8_STAGE(PG8_SB(1, 1), b3 + hstep, voffB); PG8_STAGE(PG8_SA(1, 0), a3, voffA);
            PG8_WAIT_V(8); PG8_WAIT_L(0); PG8_BAR; PG8_MMA(1, 0, At, B0); PG8_MMA(1, 1, At, B1); PG8_BAR; PG8_SCHED;
            } else {
            PG8_LDB(B0, 0, 0); PG8_SCHED; PG8_LDA(At, 0, 0); PG8_STAGE(PG8_SA(1, 1), a1 + hstep, voffA);
            PG8_WAIT_L(8); PG8_BAR; PG8_WAIT_L(0); PG8_MMA(0, 0, At, B0); PG8_BAR; PG8_SCHED;
            PG8_LDB(B1, 0, 1); PG8_STAGE(PG8_SB(0, 0), b2, voffB);
            PG8_BAR; PG8_WAIT_L(0); PG8_MMA(0, 1, At, B1); PG8_BAR;
            PG8_LDA(At, 0, 1); PG8_STAGE(PG8_SA(0, 0), a2, voffA);
            PG8_BAR; PG8_WAIT_L(0); PG8_MMA(1, 0, At, B0); PG8_BAR; PG8_SCHED;
            PG8_STAGE(PG8_SB(0, 1), b2 + hstep, voffB);
            PG8_WAIT_V(6); PG8_BAR; PG8_MMA(1, 1, At, B1); PG8_BAR;
            PG8_LDB(B0, 1, 0); PG8_SCHED; PG8_LDA(At, 1, 0); PG8_STAGE(PG8_SA(0, 1), a2 + hstep, voffA);
            PG8_WAIT_L(8); PG8_BAR; PG8_WAIT_L(0); PG8_MMA(0, 0, At, B0); PG8_BAR; PG8_SCHED;
            PG8_LDB(B1, 1, 1); PG8_STAGE(PG8_SB(1, 0), b3, voffB);
            PG8_BAR; PG8_WAIT_L(0); PG8_MMA(0, 1, At, B1); PG8_BAR;
            PG8_LDA(At, 1, 1); PG8_STAGE(PG8_SA(1, 0), a3, voffA);
            PG8_BAR; PG8_WAIT_L(0); PG8_MMA(1, 0, At, B0); PG8_BAR; PG8_SCHED;
            PG8_STAGE(PG8_SB(1, 1), b3 + hstep, voffB);
            PG8_WAIT_V(6); PG8_BAR; PG8_MMA(1, 1, At, B1); PG8_BAR;
            }
        }
        if constexpr (ALIGN_EPI) { if (wr == 0) PG8_BAR; }
        if constexpr (!Epi::AFTER_DRAIN) { E(acc, cur, wr, wc, fr, fq); S.done(cur); }
        if (!has_next) break;
#pragma unroll
        for (int a = 0; a < 2; ++a)
#pragma unroll
            for (int b = 0; b < 2; ++b)
#pragma unroll
                for (int m = 0; m < 4; ++m)
#pragma unroll
                    for (int n = 0; n < 2; ++n) acc[a][b][m][n] = (f32x4){0.f, 0.f, 0.f, 0.f};
        cur = nxt; cA = nA; cB = nB; ++ui;
        if constexpr (ALIGN_EPI) { if (wr == 1) PG8_BAR; }
    }
    PG8_WAIT_V(0);
    if constexpr (!ALIGN_EPI) { if (wr == 0) PG8_BAR; }
    PG8_BAR;
    if constexpr (Epi::AFTER_DRAIN) { E.fused(acc, cur, wr, wc, fr, fq, lds, wid, lane); S.done(cur); }
#undef PG8_SA
#undef PG8_SB
#undef PG8_STAGE
#undef PG8_LDA
#undef PG8_LDB
#undef PG8_MMA
#undef PG8_WAIT_V
#undef PG8_WAIT_L
#undef PG8_BAR
#undef PG8_SCHED
}
}
constexpr int DM = 1024, NB = 32, SEQ = 2048, DEPTH = 4, LC = 256;
constexpr int TL = NB * SEQ, TC = NB * LC, TT = TL + TC;
constexpr int DIN = 2304, DFF = 4096;
constexpr int C_RQ = 0, C_RK = 128, C_RV = 256, C_RG = 512, C_HY = 768, C_AQ = 1536, C_AK = 2048, C_AV = 2176;
constexpr float EPSN = 1e-6f, LOG2E = 1.4426950408889634f;
constexpr int NCH = 18;

constexpr size_t MiB = 1u << 20;
constexpr size_t WS_W = 2 * MiB, W_LAYER = (size_t)(2304 + 1024 + 4096 + 4096) * 1024 * 2;
constexpr size_t WO_IN = 0, WO_OUT = (size_t)2304 * 1024 * 2, WO_1 = WO_OUT + (size_t)1024 * 1024 * 2, WO_2 = WO_1 + (size_t)4096 * 1024 * 2;
constexpr size_t WS_ADA = 92 * MiB, WS_ROTR = 96 * MiB, WS_ROTA = 97 * MiB, WS_RF = 98 * MiB, WS_RC = 106 * MiB, WS_KV = 864 * MiB;
constexpr size_t OUT_ZT = 0 * MiB, OUT_ZTC = 32 * MiB, OUT_YT = 36 * MiB, OUT_YTC = 68 * MiB;
constexpr size_t WS_XB = 108 * MiB, WS_YH = 252 * MiB;
constexpr size_t WS_P = 396 * MiB, WS_MIXO = 720 * MiB, WS_U = 396 * MiB, WS_END = 972 * MiB;
constexpr int LDS_BYTES = 150 * 1024;

typedef unsigned short bf16;
typedef unsigned v4u __attribute__((ext_vector_type(4)));
typedef unsigned v2u __attribute__((ext_vector_type(2)));
typedef float f32x4 __attribute__((ext_vector_type(4)));
typedef float f32x16 __attribute__((ext_vector_type(16)));
typedef short bf16x8 __attribute__((ext_vector_type(8)));
typedef short s16x4 __attribute__((ext_vector_type(4)));
#define MFMA32(a, b, c) __builtin_amdgcn_mfma_f32_32x32x16_bf16((a), (b), (c), 0, 0, 0)
#define DI __device__ __forceinline__

DI unsigned f2bf(float f) { unsigned u = __builtin_bit_cast(unsigned, f); return (u + 0x7fffu + ((u >> 16) & 1u)) >> 16; }
typedef float f32x2_t __attribute__((ext_vector_type(2)));
typedef __bf16 bf16x2_t __attribute__((ext_vector_type(2)));
DI unsigned pk2(float lo, float hi) { const f32x2_t v = {lo, hi}; return __builtin_bit_cast(unsigned, __builtin_convertvector(v, bf16x2_t)); }
DI float bf2f(bf16 b) { return __builtin_bit_cast(float, (unsigned)b << 16); }
DI float bflo(unsigned w) { return __builtin_bit_cast(float, w << 16); }
DI float bfhi(unsigned w) { return __builtin_bit_cast(float, w & 0xffff0000u); }
template <int CTRL> DI float dpp_mov(float v) { return __builtin_bit_cast(float, __builtin_amdgcn_update_dpp(0, __builtin_bit_cast(int, v), CTRL, 0xf, 0xf, true)); }
DI float wave_sum(float v) {
    v += dpp_mov<0xB1>(v); v += dpp_mov<0x4E>(v); v += dpp_mov<0x141>(v); v += dpp_mov<0x140>(v);
    v += __shfl_xor(v, 16); v += __shfl_xor(v, 32);
    return v;
}
DI float rdlane(float v, int l) { return __builtin_bit_cast(float, __builtin_amdgcn_readlane(__builtin_bit_cast(int, v), l)); }

DI int otid() { int t = threadIdx.x; asm volatile("" : "+v"(t)); return t; }
DI size_t ozero() { size_t z = 0; asm volatile("" : "+s"(z)); return z; }
DI unsigned ozero32() { unsigned z = 0; asm volatile("" : "+s"(z)); return z; }
struct Args { const float* in[29]; float* out; unsigned char* ws; };

DI void p0_transpose_item(const float* W, int K, int N, bf16* WT, float* scr, int item, int lane) {
    const int nblk = N / 32, kb = item / nblk, nb = item % nblk, k0 = 64 * kb, n0 = 32 * nb;
    float wv[32];
#pragma unroll
    for (int i = 0; i < 32; ++i) wv[i] = W[(size_t)(k0 + 2 * i + (lane >> 5)) * N + n0 + (lane & 31)];
#pragma unroll
    for (int i = 0; i < 32; ++i) scr[(2 * i + (lane >> 5)) * 33 + (lane & 31)] = wv[i];
    asm volatile("s_waitcnt lgkmcnt(0)" ::: "memory");
    const int c = lane & 7;
#pragma unroll
    for (int j = 0; j < 4; ++j) { const int n = (lane >> 3) + 8 * j; const float* s = scr + (8 * c) * 33 + n;
        v4u o; o.x = pk2(s[0 * 33], s[1 * 33]); o.y = pk2(s[2 * 33], s[3 * 33]); o.z = pk2(s[4 * 33], s[5 * 33]); o.w = pk2(s[6 * 33], s[7 * 33]);
        *(v4u*)(WT + (size_t)(n0 + n) * K + k0 + 8 * c) = o; }
    asm volatile("s_waitcnt lgkmcnt(0)" ::: "memory");
}

DI void p0_prologue(const Args& a, unsigned char* lds, int bid, int G) {
    const int tid = otid(), lane = tid & 63, wave = tid >> 6;
    const int gw = bid * 8 + wave, NGW = G * 8;
    unsigned char* ws = a.ws;
#pragma unroll 1
    for (int ph = 0; ph < 2; ++ph) {
    if (((wave & 1) == 0) == (ph == 0)) {
    {
        float* scr = (float*)(lds + wave * 16384);
        constexpr int I_IN = 16 * 72, I_OUT = 16 * 32, I_1 = 16 * 128, I_2 = 64 * 32, I_L = I_IN + I_OUT + I_1 + I_2;
        for (int it = gw; it < DEPTH * I_L; it += NGW) {
            const int l = it / I_L; int r = it % I_L; unsigned char* wl = ws + WS_W + (size_t)l * W_LAYER;
            if (r < I_IN) { p0_transpose_item(a.in[10] + (size_t)l * 1024 * 2304, 1024, 2304, (bf16*)(wl + WO_IN), scr, r, lane); continue; } r -= I_IN;
            if (r < I_OUT) { p0_transpose_item(a.in[26] + (size_t)l * 1024 * 1024, 1024, 1024, (bf16*)(wl + WO_OUT), scr, r, lane); continue; } r -= I_OUT;
            if (r < I_1) { p0_transpose_item(a.in[27] + (size_t)l * 1024 * 4096, 1024, 4096, (bf16*)(wl + WO_1), scr, r, lane); continue; } r -= I_1;
            p0_transpose_item(a.in[28] + (size_t)l * 4096 * 1024, 4096, 1024, (bf16*)(wl + WO_2), scr, r, lane);
        }
    }
    } else {
    {
        for (int it = gw; it < DEPTH * 2304; it += NGW) {
            const int l = it / 2304, rp = it % 2304; const int LQ = rp < 2048 ? 2048 : 256; const int p = rp < 2048 ? rp : rp - 2048;
            const float* w1 = a.in[15] + (size_t)l * 33 * 64; const float* b1 = a.in[16] + l * 64; const float* w2 = a.in[17] + (size_t)l * 2 * 64 * 64; const float* b2 = a.in[18] + l * 2 * 64;
            const float* w3 = a.in[19] + (size_t)l * 64 * 512; const float fr = a.in[20][l * 64 + lane];
            const float t = (float)p / (float)(LQ - 1); const float w = 6.283185307179586f * (float)p / (float)LQ;
            float zval = 0.f;
            if (lane == 0) zval = t;
            else if (lane <= 32) { const int bi = (lane - 1) & 15; const float band = 1e-4f + (float)bi * ((15.0f - 1e-4f) / 15.0f); const float ang = w * band; zval = lane <= 16 ? cosf(ang) : -sinf(ang); }
            float acc = b1[lane];
#pragma unroll
            for (int e = 0; e < 33; ++e) acc += rdlane(zval, e) * w1[e * 64 + lane];
            float h = sinf(fr * acc);
#pragma unroll 1
            for (int jj = 0; jj < 2; ++jj) { acc = b2[jj * 64 + lane];
#pragma unroll
                for (int i = 0; i < 64; ++i) acc += rdlane(h, i) * w2[(jj * 64 + i) * 64 + lane];
                h = sinf(fr * acc); }
            bf16* R = (LQ == 2048) ? (bf16*)(ws + WS_RF) + ((size_t)l * 256) * 4096 : (bf16*)(ws + WS_RC) + ((size_t)l * 256) * 512;
            const int RS = 2 * LQ;
#pragma unroll 1
            for (int o = 0; o < 8; ++o) { const int col = lane + 64 * o; float s = 0.f;
#pragma unroll
                for (int i = 0; i < 64; ++i) s += rdlane(h, i) * w3[i * 512 + col];
                const int c = col & 255; const float delta = 3.0701134573253945f + (float)c * ((15.350567286626973f - 3.0701134573253945f) / 255.0f);
                const float val = s * expf(-t * delta);
                if (col < 256) R[(size_t)c * RS + (LQ - 1 - p)] = (bf16)f2bf(val);
                else if (p >= 1) R[(size_t)c * RS + (LQ - 1 + p)] = (bf16)f2bf(val); }
            if (p == 0) { for (int c = lane; c < 256; c += 64) R[(size_t)c * RS + RS - 1] = 0; }
        }
    }
    }
    }
    {
        float* rotr = (float*)(ws + WS_ROTR); float* rota = (float*)(ws + WS_ROTA);
        for (int i = bid * 512 + tid; i < 2048 * 16; i += G * 512) { const int pos = i >> 4, f = i & 15;
            const float invr = 1.0f / powf(10000.0f, (float)f / 15.0f); const float ang = (float)pos * invr;
            rotr[pos * 32 + f] = cosf(ang); rotr[pos * 32 + 16 + f] = sinf(ang);
            const float inva = powf(10000.0f, -(float)f / 16.0f); const float ar = (float)(pos >> 6) * inva, ac = (float)(pos & 63) * inva;
            rota[pos * 64 + f] = cosf(ar); rota[pos * 64 + 16 + f] = sinf(ar); rota[pos * 64 + 32 + f] = cosf(ac); rota[pos * 64 + 48 + f] = sinf(ac); }
    }
    __syncthreads();
    {
        float* sil = (float*)lds + wave * (33 * 64);
        float* red = (float*)lds + 8 * 33 * 64;
        float* ada = (float*)(ws + WS_ADA);
        for (int it = bid; it < DEPTH * 96; it += G) {
            const int l = it / 96, n0 = (it % 96) * 64;
            const float* wa = a.in[4] + (size_t)l * 1024 * 6144;
            float acc[33];
#pragma unroll
            for (int b = 0; b < 33; ++b) acc[b] = 0.f;
#pragma unroll 1
            for (int kc = 0; kc < 2; ++kc) { const int k0 = wave * 128 + kc * 64;
#pragma unroll 1
                for (int b = 0; b < 33; ++b) { const float cv = b < 32 ? a.in[1][b * 1024 + k0 + lane] : a.in[3][k0 + lane]; sil[b * 64 + lane] = cv / (1.f + expf(-cv)); }
                asm volatile("s_waitcnt lgkmcnt(0)" ::: "memory");
#pragma unroll 2
                for (int kk = 0; kk < 64; kk += 4) { const float* wp = wa + (size_t)(k0 + kk) * 6144 + n0 + lane;
                    const float w0 = wp[0], w1 = wp[6144], w2 = wp[2 * 6144], w3 = wp[3 * 6144];
#pragma unroll
                    for (int b = 0; b < 33; ++b) { const f32x4 q = *(const f32x4*)(sil + b * 64 + kk); acc[b] += (q.x * w0 + q.y * w1) + (q.z * w2 + q.w * w3); } }
                asm volatile("s_waitcnt lgkmcnt(0)" ::: "memory");
            }
#pragma unroll
            for (int b = 0; b < 33; ++b) red[(wave * 33 + b) * 64 + lane] = acc[b];
            __syncthreads();
            for (int o = tid; o < 33 * 64; o += 512) { float s = a.in[5][l * 6144 + n0 + (o & 63)];
#pragma unroll
                for (int w8 = 0; w8 < 8; ++w8) s += red[w8 * 33 * 64 + o];
                ada[((size_t)l * 33 + (o >> 6)) * 6144 + n0 + (o & 63)] = s; }
            __syncthreads();
        }
    }
}

DI void ew_phase(const float* xin_lat, const float* xin_ctx, const bf16* xin_b, float* xout_lat, float* xout_ctx, bf16* xout_b, const bf16* Y, const float* ada_g, int goff, const float* g_post,
                 bf16* H, const float* ada_h, int shoff, int scoff, const float* g_pre, int nrows, int bid, int G) {
    const int tid = otid(); const int lane = tid & 63, wave = tid >> 6;
    const int perb = (nrows + G - 1) / G; const int r0 = bid * perb + wave, r1 = min(nrows, (bid + 1) * perb);
    f32x4 gpo[4], gpr[4], gt[4], sh[4], sc[4];
#pragma unroll
    for (int j = 0; j < 4; ++j) { gpo[j] = Y ? *(const f32x4*)(g_post + 4 * lane + 256 * j) : (f32x4){0.f, 0.f, 0.f, 0.f}; gpr[j] = H ? *(const f32x4*)(g_pre + 4 * lane + 256 * j) : (f32x4){0.f, 0.f, 0.f, 0.f};
        gt[j] = (f32x4){0.f, 0.f, 0.f, 0.f}; sh[j] = gt[j]; sc[j] = gt[j]; }
    int curb = -1;
#pragma unroll 1
    for (int r = r0; r < r1; r += 8) {
        const bool lat = r < TL; const int b = lat ? (r >> 11) : 32;
        f32x4 v[4];
        if (xin_b) {
#pragma unroll
            for (int j = 0; j < 4; ++j) { const v2u w = __builtin_nontemporal_load((const v2u*)(xin_b + (size_t)r * DM + 4 * lane + 256 * j)); v[j] = (f32x4){bflo(w.x), bfhi(w.x), bflo(w.y), bfhi(w.y)}; }
        } else { const float* xr = lat ? xin_lat + (size_t)r * DM : xin_ctx + (size_t)(r - TL) * DM;
#pragma unroll
            for (int j = 0; j < 4; ++j) v[j] = *(const f32x4*)(xr + 4 * lane + 256 * j); }
        v2u yw[4];
        if (Y) {
#pragma unroll
            for (int j = 0; j < 4; ++j) yw[j] = __builtin_nontemporal_load((const v2u*)(Y + (size_t)r * DM + 4 * lane + 256 * j));
        }
        if (b != curb) { curb = b;
#pragma unroll
            for (int j = 0; j < 4; ++j) { if (Y) gt[j] = *(const f32x4*)(ada_g + (size_t)b * 6144 + goff + 4 * lane + 256 * j);
                if (H) { sh[j] = *(const f32x4*)(ada_h + (size_t)b * 6144 + shoff + 4 * lane + 256 * j); sc[j] = *(const f32x4*)(ada_h + (size_t)b * 6144 + scoff + 4 * lane + 256 * j) + 1.0f; } } }
        if (Y) {
            f32x4 y[4]; float ss = 0.f;
#pragma unroll
            for (int j = 0; j < 4; ++j) { y[j] = (f32x4){bflo(yw[j].x), bfhi(yw[j].x), bflo(yw[j].y), bfhi(yw[j].y)};
                ss += y[j].x * y[j].x + y[j].y * y[j].y + y[j].z * y[j].z + y[j].w * y[j].w; }
            const float rinv = 1.0f / sqrtf(wave_sum(ss) * (1.0f / DM) + EPSN);
#pragma unroll
            for (int j = 0; j < 4; ++j) v[j] = v[j] + gt[j] * (y[j] * rinv * gpo[j]);
            if (xout_b) {
#pragma unroll
                for (int j = 0; j < 4; ++j) { v2u w; w.x = pk2(v[j].x, v[j].y); w.y = pk2(v[j].z, v[j].w); __builtin_nontemporal_store(w, (v2u*)(xout_b + (size_t)r * DM + 4 * lane + 256 * j)); }
            } else { float* xo = lat ? xout_lat + (size_t)r * DM : xout_ctx + (size_t)(r - TL) * DM;
#pragma unroll
                for (int j = 0; j < 4; ++j) *(f32x4*)(xo + 4 * lane + 256 * j) = v[j]; }
        }
        if (H) {
            float ss = 0.f;
#pragma unroll
            for (int j = 0; j < 4; ++j) ss += v[j].x * v[j].x + v[j].y * v[j].y + v[j].z * v[j].z + v[j].w * v[j].w;
            const float rinv = 1.0f / sqrtf(wave_sum(ss) * (1.0f / DM) + EPSN);
#pragma unroll
            for (int j = 0; j < 4; ++j) { const f32x4 hv = (v[j] * rinv * gpr[j]) * sc[j] + sh[j];
                v2u w; w.x = pk2(hv.x, hv.y); w.y = pk2(hv.z, hv.w); *(v2u*)(H + (size_t)r * DM + 4 * lane + 256 * j) = w; }
        }
    }
}

DI void attn_item(const bf16* P, bf16* MIXO, const float* sinkp, const float* g_att, unsigned char* lds, int qrow0, int qpos0, int brow_lat, int brow_ctx, bool is_ctx) {
    const int tid = otid(), lane = tid & 63, w = tid >> 6, g = w >> 2, r = lane & 31, h = lane >> 5;
    constexpr int KVB = 2 * 2 * 64 * 72;
    bf16* KV0 = (bf16*)lds;
    float* ssq = (float*)(lds + 2 * KVB * 2);
    bf16* Ql = (bf16*)(lds + 2 * KVB * 2 + 2048) + w * (64 * 72);
    const int bi0 = is_ctx ? 0 : (qpos0 >= 128 ? 0 : (qpos0 >= 64 ? 1 : 2));
    const int bi1 = is_ctx ? -1 : min(4, (SEQ + 127 - qpos0) >> 6);
    const int nband = is_ctx ? 0 : bi1 - bi0 + 1, ntiles = nband + 4;
    const int skey = tid & 63, spart = tid >> 6;
    v4u pk[2], pv[2];
#define ATT_TILE_ROW(t) ((t) < nband ? brow_lat + qpos0 - 128 + 64 * (bi0 + (t)) : brow_ctx + 64 * ((t) - nband))
#define ATT_LOAD(t) do { const bf16* src_ = P + (size_t)(ATT_TILE_ROW(t) + skey) * DIN + 8 * spart; \
        pk[0] = *(const v4u*)(src_ + C_AK); pk[1] = *(const v4u*)(src_ + C_AK + 64); pv[0] = *(const v4u*)(src_ + C_AV); pv[1] = *(const v4u*)(src_ + C_AV + 64); } while (0)
#define ATT_STORE(buf) do { bf16* Kd_ = KV0 + (buf) * KVB; bf16* Vd_ = Kd_ + 2 * 64 * 72; \
        _Pragma("unroll") for (int gg = 0; gg < 2; ++gg) { *(v4u*)(Kd_ + (gg * 64 + skey) * 72 + 8 * spart) = pk[gg]; \
            bf16* vd = Vd_ + (gg * 64 + 8 * spart) * 72 + skey; const v4u vv = pv[gg]; \
            vd[0 * 72] = (bf16)(vv.x & 0xffffu); vd[1 * 72] = (bf16)(vv.x >> 16); vd[2 * 72] = (bf16)(vv.y & 0xffffu); vd[3 * 72] = (bf16)(vv.y >> 16); \
            vd[4 * 72] = (bf16)(vv.z & 0xffffu); vd[5 * 72] = (bf16)(vv.z >> 16); vd[6 * 72] = (bf16)(vv.w & 0xffffu); vd[7 * 72] = (bf16)(vv.w >> 16); } } while (0)
    ATT_LOAD(0);
#pragma unroll
    for (int i = 0; i < 8; ++i) { const int c = lane + 64 * i, row = c >> 3, part = c & 7;
        *(v4u*)(Ql + row * 72 + 8 * part) = *(const v4u*)(P + (size_t)(qrow0 + row) * DIN + C_AQ + 64 * w + 8 * part); }
    f32x16 O[2][2];
#pragma unroll
    for (int qb = 0; qb < 2; ++qb)
#pragma unroll
        for (int db = 0; db < 2; ++db)
#pragma unroll
            for (int i = 0; i < 16; ++i) O[qb][db][i] = 0.f;
    const float sk = sinkp[w] * LOG2E;
    float mrun[2] = {sk, sk}, lrun[2] = {h == 0 ? 1.f : 0.f, h == 0 ? 1.f : 0.f};
    __syncthreads();
    ATT_STORE(0);
#pragma unroll 1
    for (int t = 0; t < ntiles; ++t) {
        const bool band = t < nband; const int bi = bi0 + t;
        const int kpos0 = qpos0 - 128 + 64 * bi; const bool need_mask = band && (bi == 0 || bi == 4);
        if (t + 1 < ntiles) ATT_LOAD(t + 1);
        __syncthreads();
        const bf16* Kl = KV0 + (t & 1) * KVB; const bf16* Vl = Kl + 2 * 64 * 72;
        bf16x8 Kf[2][4], Pf[2][2][2];
#pragma unroll
        for (int kb = 0; kb < 2; ++kb)
#pragma unroll
            for (int s = 0; s < 4; ++s) Kf[kb][s] = *(const bf16x8*)(Kl + (g * 64 + 32 * kb + r) * 72 + 16 * s + 8 * h);
#pragma unroll
        for (int qb = 0; qb < 2; ++qb) {
            f32x16 S[2];
#pragma unroll
            for (int kb = 0; kb < 2; ++kb)
#pragma unroll
                for (int i = 0; i < 16; ++i) S[kb][i] = 0.f;
#pragma unroll
            for (int s = 0; s < 4; ++s) { const bf16x8 qf = *(const bf16x8*)(Ql + (32 * qb + r) * 72 + 16 * s + 8 * h);
                S[0] = MFMA32(Kf[0][s], qf, S[0]); S[1] = MFMA32(Kf[1][s], qf, S[1]); }
            if (need_mask) { const int qp = qpos0 + 32 * qb + r;
#pragma unroll
                for (int kb = 0; kb < 2; ++kb)
#pragma unroll
                    for (int i = 0; i < 16; ++i) { const int kp = kpos0 + 32 * kb + (i & 3) + 8 * (i >> 2) + 4 * h; const int d = kp - qp; if (d > 128 || d < -128) S[kb][i] = -1e30f; } }
            float mx = fmaxf(S[0][0], S[1][0]);
#pragma unroll
            for (int i = 1; i < 16; ++i) mx = fmaxf(mx, fmaxf(S[0][i], S[1][i]));
            float mnew = mrun[qb];
            if (__builtin_amdgcn_ballot_w64(mx > mrun[qb]) != 0ull) {
                mx = fmaxf(mx, __shfl_xor(mx, 32));
                mnew = fmaxf(mrun[qb], mx);
                const float alpha = __builtin_amdgcn_exp2f(mrun[qb] - mnew);
                lrun[qb] *= alpha;
#pragma unroll
                for (int db = 0; db < 2; ++db)
#pragma unroll
                    for (int i = 0; i < 16; ++i) O[qb][db][i] *= alpha;
            }
            float ps = 0.f;
#pragma unroll
            for (int kb = 0; kb < 2; ++kb)
#pragma unroll
                for (int i = 0; i < 16; ++i) { S[kb][i] = __builtin_amdgcn_exp2f(S[kb][i] - mnew); ps += S[kb][i]; }
            lrun[qb] += ps; mrun[qb] = mnew;
#pragma unroll
            for (int kb = 0; kb < 2; ++kb)
#pragma unroll
                for (int u = 0; u < 2; ++u) { v4u pw; pw.x = pk2(S[kb][8 * u + 0], S[kb][8 * u + 1]); pw.y = pk2(S[kb][8 * u + 2], S[kb][8 * u + 3]); pw.z = pk2(S[kb][8 * u + 4], S[kb][8 * u + 5]); pw.w = pk2(S[kb][8 * u + 6], S[kb][8 * u + 7]);
                    Pf[qb][kb][u] = __builtin_bit_cast(bf16x8, pw); }
        }
#pragma unroll
        for (int kb = 0; kb < 2; ++kb) {
            bf16x8 Vf[2][2];
#pragma unroll
            for (int db = 0; db < 2; ++db)
#pragma unroll
                for (int u = 0; u < 2; ++u) { const bf16* vp = Vl + (g * 64 + 32 * db + r) * 72 + 32 * kb + 16 * u + 4 * h;
                    const s16x4 lo = *(const s16x4*)vp, hi = *(const s16x4*)(vp + 8);
                    Vf[db][u] = __builtin_shufflevector(lo, hi, 0, 1, 2, 3, 4, 5, 6, 7); }
#pragma unroll
            for (int qb = 0; qb < 2; ++qb)
#pragma unroll
                for (int db = 0; db < 2; ++db)
#pragma unroll
                    for (int u = 0; u < 2; ++u) O[qb][db] = MFMA32(Vf[db][u], Pf[qb][kb][u], O[qb][db]);
        }
        if (t + 1 < ntiles) ATT_STORE((t + 1) & 1);
    }
#undef ATT_TILE_ROW
#undef ATT_LOAD
#undef ATT_STORE
#pragma unroll
    for (int qb = 0; qb < 2; ++qb) {
        const float lt = lrun[qb] + __shfl_xor(lrun[qb], 32); const float inv = 1.0f / lt; float ss = 0.f;
#pragma unroll
        for (int db = 0; db < 2; ++db)
#pragma unroll
            for (int i = 0; i < 16; ++i) { O[qb][db][i] *= inv; ss += O[qb][db][i] * O[qb][db][i]; }
        ss += __shfl_xor(ss, 32);
        if (h == 0) ssq[w * 64 + 32 * qb + r] = ss;
    }
    __syncthreads();
#pragma unroll
    for (int qb = 0; qb < 2; ++qb) {
        float tot = 0.f;
#pragma unroll
        for (int w8 = 0; w8 < 8; ++w8) tot += ssq[w8 * 64 + 32 * qb + r];
        const float rinv = 1.0f / sqrtf(tot * (1.0f / 512.0f) + EPSN);
        bf16* orow = MIXO + (size_t)(qrow0 + 32 * qb + r) * DM + 512 + 64 * w;
#pragma unroll
        for (int db = 0; db < 2; ++db)
#pragma unroll
            for (int i4 = 0; i4 < 4; ++i4) { const int d = 32 * db + 8 * i4 + 4 * h; const f32x4 gg = *(const f32x4*)(g_att + 64 * w + d);
                v2u o; o.x = pk2(O[qb][db][4 * i4 + 0] * rinv * gg.x, O[qb][db][4 * i4 + 1] * rinv * gg.y); o.y = pk2(O[qb][db][4 * i4 + 2] * rinv * gg.z, O[qb][db][4 * i4 + 3] * rinv * gg.w);
                *(v2u*)(orow + d) = o; }
    }
    __syncthreads();
}

DI float ldhy(const bf16* P, int rowbase, int t, int LQ, int col) { return (t >= 0 && t < LQ) ? bf2f(P[(size_t)(rowbase + t) * DIN + C_HY + col]) : 0.f; }

DI v4u ldrow8(const bf16* P, int rowbase, int t, int LQ, int col) { v4u z = {0u, 0u, 0u, 0u}; return (t >= 0 && t < LQ) ? *(const v4u*)(P + (size_t)(rowbase + t) * DIN + C_HY + col) : z; }
DI float bfsel(const v4u& q, int k) { const unsigned w = (k >> 1) == 0 ? q.x : ((k >> 1) == 1 ? q.y : ((k >> 1) == 2 ? q.z : q.w)); return (k & 1) ? bfhi(w) : bflo(w); }
DI void hypre_item(const bf16* P, const float* sw, const float* sbias, bf16* Zt, unsigned char* lds, int rowbase, int b, int t0, int LQ) {
    const int tid = otid(); bf16* zl = (bf16*)lds;
    { const size_t oz = ozero(); sw += oz; sbias += oz; }
    const int lane = tid & 63, ts = lane & 15, cg = (tid >> 6) * 4 + (lane >> 4), c0 = 8 * cg, tb = t0 + 4 * ts;
    __syncthreads();
    v4u rv[6], rx[6];
#pragma unroll
    for (int i = 0; i < 6; ++i) { rv[i] = ldrow8(P, rowbase, tb - 1 + i, LQ, c0); rx[i] = ldrow8(P, rowbase, tb - 1 + i, LQ, 256 + c0); }
#pragma unroll
    for (int k = 0; k < 8; ++k) {
        const float w0v = sw[c0 + k], w1v = sw[768 + c0 + k], w2v = sw[1536 + c0 + k], bv = sbias[c0 + k];
        const float w0x = sw[256 + c0 + k], w1x = sw[768 + 256 + c0 + k], w2x = sw[1536 + 256 + c0 + k], bx = sbias[256 + c0 + k];
        float z[4];
#pragma unroll
        for (int tt = 0; tt < 4; ++tt) { const float uv = w0v * bfsel(rv[tt], k) + w1v * bfsel(rv[tt + 1], k) + w2v * bfsel(rv[tt + 2], k) + bv;
            const float ux = w0x * bfsel(rx[tt], k) + w1x * bfsel(rx[tt + 1], k) + w2x * bfsel(rx[tt + 2], k) + bx; z[tt] = uv * ux; }
        v2u o; o.x = pk2(z[0], z[1]); o.y = pk2(z[2], z[3]);
        *(v2u*)(zl + (c0 + k) * 72 + 4 * ts) = o; }
    __syncthreads();
    { const int c2 = tid >> 1, hh = tid & 1;
#pragma unroll
      for (int i = 0; i < 4; ++i) *(v4u*)(Zt + ((size_t)c2 * 32 + b) * LQ + t0 + 32 * hh + 8 * i) = *(const v4u*)(zl + c2 * 72 + 32 * hh + 8 * i); }
}

template <int LQ> DI void hyconv_item(const bf16* Ztc, const bf16* R, bf16* Ytc, unsigned char* lds) {
    constexpr int ZS = LQ + 8;
    const int tid = otid(), lane = tid & 63, wave = tid >> 6, r = lane & 31, h = lane >> 5;
    bf16* Zl = (bf16*)lds; bf16* R0 = Zl + 32 * ZS; bf16* R1 = R0 + 2 * LQ;
    __syncthreads();
    for (int c = tid; c < 32 * LQ / 8; c += 512) { const int b = c / (LQ / 8), part = c % (LQ / 8); *(v4u*)(Zl + b * ZS + 8 * part) = *(const v4u*)(Ztc + (size_t)b * LQ + 8 * part); }
    for (int x = tid; x < 2 * LQ; x += 512) { R0[x] = R[x]; R1[x] = (x + 1 < 2 * LQ) ? R[x + 1] : (bf16)0; }
    __syncthreads();
    constexpr int TPW = LQ / 8 / 32;
    const int tw = wave * (LQ / 8);
    f32x16 acc[TPW];
#pragma unroll
    for (int k = 0; k < TPW; ++k)
#pragma unroll
        for (int i = 0; i < 16; ++i) acc[k][i] = 0.f;
    const bf16* abase = (r & 1) ? (R0 + (LQ - 1) - r + 8 * h) : (R1 + (LQ - 2) - r + 8 * h);
    const bf16* bbase = Zl + r * ZS + 8 * h;
    const int dmid0 = tw + 32 * (TPW - 1) - (LQ - 16), dmid1 = tw;
#pragma unroll 1
    for (int d = tw - (LQ - 16); d <= tw + 32 * (TPW - 1); d += 16) {
        if (d == dmid0) {
#pragma unroll 1
            for (; d <= dmid1; d += 16) {
                const unsigned* ap = (const unsigned*)(abase - d);
                v4u av; av.x = ap[0]; av.y = ap[1]; av.z = ap[2]; av.w = ap[3];
                const bf16x8 A = __builtin_bit_cast(bf16x8, av);
                bf16x8 Bv[TPW];
#pragma unroll
                for (int k = 0; k < TPW; ++k) Bv[k] = *(const bf16x8*)(bbase + (tw + 32 * k - d));
#pragma unroll
                for (int k = 0; k < TPW; ++k) acc[k] = MFMA32(A, Bv[k], acc[k]);
            }
            if (d > tw + 32 * (TPW - 1)) break;
        }
        const unsigned* ap = (const unsigned*)(abase - d);
        v4u av; av.x = ap[0]; av.y = ap[1]; av.z = ap[2]; av.w = ap[3];
        const bf16x8 A = __builtin_bit_cast(bf16x8, av);
#pragma unroll
        for (int k = 0; k < TPW; ++k) { const int s0 = tw + 32 * k - d;
            if (s0 >= 0 && s0 < LQ) { const bf16x8 B = *(const bf16x8*)(bbase + s0); acc[k] = MFMA32(A, B, acc[k]); } }
    }
#pragma unroll
    for (int k = 0; k < TPW; ++k)
#pragma unroll
        for (int i4 = 0; i4 < 4; ++i4) { const int t = tw + 32 * k + 8 * i4 + 4 * h;
            v2u o; o.x = pk2(acc[k][4 * i4 + 0], acc[k][4 * i4 + 1]); o.y = pk2(acc[k][4 * i4 + 2], acc[k][4 * i4 + 3]);
            *(v2u*)(Ytc + (size_t)r * LQ + t) = o; }
}

DI void hypost_item(const bf16* P, const float* sw, const float* sbias, const float* hbias, const float* g_hy, const bf16* Yt, bf16* MIXO, unsigned char* lds, int rowbase, int b, int t0, int LQ) {
    const int tid = otid(), lane = tid & 63, wave = tid >> 6;
    bf16* yl = (bf16*)lds; float* ol = (float*)(lds + 256 * 72 * 2);
    { const size_t oz = ozero(); sw += oz; sbias += oz; hbias += oz; g_hy += oz; }
    const int ts = lane & 15, cg = wave * 4 + (lane >> 4), c0 = 8 * cg, tb = t0 + 4 * ts;
    __syncthreads();
    { const int c2 = tid >> 1, hh = tid & 1;
#pragma unroll
      for (int i = 0; i < 4; ++i) *(v4u*)(yl + c2 * 72 + 32 * hh + 8 * i) = *(const v4u*)(Yt + ((size_t)c2 * 32 + b) * LQ + t0 + 32 * hh + 8 * i); }
    v4u rv[6], rx[6], ro[6];
#pragma unroll
    for (int i = 0; i < 6; ++i) { rv[i] = ldrow8(P, rowbase, tb - 1 + i, LQ, c0); rx[i] = ldrow8(P, rowbase, tb - 1 + i, LQ, 256 + c0); ro[i] = ldrow8(P, rowbase, tb - 1 + i, LQ, 512 + c0); }
    __syncthreads();
    float res[4][8];
#pragma unroll
    for (int k = 0; k < 8; ++k) {
        const float w0v = sw[c0 + k], w1v = sw[768 + c0 + k], w2v = sw[1536 + c0 + k], bv = sbias[c0 + k];
        const float w0x = sw[256 + c0 + k], w1x = sw[768 + 256 + c0 + k], w2x = sw[1536 + 256 + c0 + k], bx = sbias[256 + c0 + k];
        const float w0o = sw[512 + c0 + k], w1o = sw[768 + 512 + c0 + k], w2o = sw[1536 + 512 + c0 + k], bo = sbias[512 + c0 + k];
        const float hb = hbias[c0 + k];
        const v2u yq = *(const v2u*)(yl + (c0 + k) * 72 + 4 * ts);
        const float yv[4] = {bflo(yq.x), bfhi(yq.x), bflo(yq.y), bfhi(yq.y)};
#pragma unroll
        for (int tt = 0; tt < 4; ++tt) { const float uv = w0v * bfsel(rv[tt], k) + w1v * bfsel(rv[tt + 1], k) + w2v * bfsel(rv[tt + 2], k) + bv;
            const float ux = w0x * bfsel(rx[tt], k) + w1x * bfsel(rx[tt + 1], k) + w2x * bfsel(rx[tt + 2], k) + bx;
            const float uo = w0o * bfsel(ro[tt], k) + w1o * bfsel(ro[tt + 1], k) + w2o * bfsel(ro[tt + 2], k) + bo;
            res[tt][k] = (yv[tt] + uv * ux * hb) * uo; } }
#pragma unroll
    for (int tt = 0; tt < 4; ++tt) { float* od = ol + (4 * ts + tt) * 260 + c0;
        *(f32x4*)od = (f32x4){res[tt][0], res[tt][1], res[tt][2], res[tt][3]}; *(f32x4*)(od + 4) = (f32x4){res[tt][4], res[tt][5], res[tt][6], res[tt][7]}; }
    __syncthreads();
    { const int tt = 8 * wave + (lane >> 3), sub = lane & 7;
      f32x4 v[8]; float ss = 0.f;
#pragma unroll
      for (int q = 0; q < 8; ++q) { v[q] = *(const f32x4*)(ol + tt * 260 + 4 * sub + 32 * q); ss += v[q].x * v[q].x + v[q].y * v[q].y + v[q].z * v[q].z + v[q].w * v[q].w; }
      ss += dpp_mov<0xB1>(ss); ss += dpp_mov<0x4E>(ss); ss += dpp_mov<0x141>(ss);
      const float rinv = 1.0f / sqrtf(ss * (1.0f / 256.0f) + EPSN);
      bf16* orow = MIXO + (size_t)(rowbase + t0 + tt) * DM + 256 + 4 * sub;
#pragma unroll
      for (int q = 0; q < 8; ++q) { const f32x4 gg = *(const f32x4*)(g_hy + 4 * sub + 32 * q);
          v2u o; o.x = pk2(v[q].x * rinv * gg.x, v[q].y * rinv * gg.y); o.y = pk2(v[q].z * rinv * gg.z, v[q].w * rinv * gg.w);
          *(v2u*)(orow + 32 * q) = o; } }
}

DI int ret_rowbase(int b, int np) { return np < 2 ? TL + b * LC + 128 * np : b * SEQ + 128 * (np - 2); }
DI float ret_l2g(const float* dec, int h) { return log1pf(-expf(dec[h])) * LOG2E; }

DI void ret_stage_vt(const bf16* P, int rowbase, bf16* VT, int tid) {
#pragma unroll 2
    for (int i = 0; i < 8; ++i) { const int c = tid + 512 * i, part = c >> 7, j = c & 127;
        const v4u q = *(const v4u*)(P + (size_t)(rowbase + j) * DIN + C_RV + 8 * part);
        bf16* vd = VT + (8 * part) * 136 + j;
        vd[0 * 136] = (bf16)(q.x & 0xffffu); vd[1 * 136] = (bf16)(q.x >> 16); vd[2 * 136] = (bf16)(q.y & 0xffffu); vd[3 * 136] = (bf16)(q.y >> 16);
        vd[4 * 136] = (bf16)(q.z & 0xffffu); vd[5 * 136] = (bf16)(q.z >> 16); vd[6 * 136] = (bf16)(q.w & 0xffffu); vd[7 * 136] = (bf16)(q.w >> 16); }
}

DI void retkv_mfma_item(const bf16* P, float* KV, const float* dec_f, const float* dec_b, unsigned char* lds, int b, int np) {
    const int tid = otid(), lane = tid & 63, w = tid >> 6, r = lane & 31, hh = lane >> 5;
    bf16* VT = (bf16*)lds; bf16* KFT = VT + 4 * 64 * 136; bf16* KBT = KFT + 4 * 32 * 136;
    const int rowbase = ret_rowbase(b, np);
    __syncthreads();
    ret_stage_vt(P, rowbase, VT, tid);
#pragma unroll 2
    for (int i = 0; i < 4; ++i) { const int c = tid + 512 * i, part = c >> 7, j = c & 127, h = part >> 2;
        const float l2f = ret_l2g(dec_f, h), l2b = ret_l2g(dec_b, h);
        const float wf = exp2f(l2f * (float)(127 - j)), wb = exp2f(l2b * (float)j);
        const v4u q = *(const v4u*)(P + (size_t)(rowbase + j) * DIN + C_RK + 8 * part);
        const float k0 = bflo(q.x), k1 = bfhi(q.x), k2 = bflo(q.y), k3 = bfhi(q.y), k4 = bflo(q.z), k5 = bfhi(q.z), k6 = bflo(q.w), k7 = bfhi(q.w);
        bf16* fd = KFT + (8 * part) * 136 + j; bf16* bd = KBT + (8 * part) * 136 + j;
        fd[0 * 136] = (bf16)f2bf(k0 * wf); fd[1 * 136] = (bf16)f2bf(k1 * wf); fd[2 * 136] = (bf16)f2bf(k2 * wf); fd[3 * 136] = (bf16)f2bf(k3 * wf);
        fd[4 * 136] = (bf16)f2bf(k4 * wf); fd[5 * 136] = (bf16)f2bf(k5 * wf); fd[6 * 136] = (bf16)f2bf(k6 * wf); fd[7 * 136] = (bf16)f2bf(k7 * wf);
        bd[0 * 136] = (bf16)f2bf(k0 * wb); bd[1 * 136] = (bf16)f2bf(k1 * wb); bd[2 * 136] = (bf16)f2bf(k2 * wb); bd[3 * 136] = (bf16)f2bf(k3 * wb);
        bd[4 * 136] = (bf16)f2bf(k4 * wb); bd[5 * 136] = (bf16)f2bf(k5 * wb); bd[6 * 136] = (bf16)f2bf(k6 * wb); bd[7 * 136] = (bf16)f2bf(k7 * wb); }
    __syncthreads();
    const int h = w & 3, dir = w >> 2;
    const bf16* KT = (dir ? KBT : KFT) + (h * 32 + r) * 136 + 8 * hh;
    const bf16* VB = VT + (h * 64 + r) * 136 + 8 * hh;
    f32x16 C[2];
#pragma unroll
    for (int eb = 0; eb < 2; ++eb)
#pragma unroll
        for (int i = 0; i < 16; ++i) C[eb][i] = 0.f;
#pragma unroll
    for (int ks = 0; ks < 8; ++ks) { const bf16x8 A = *(const bf16x8*)(KT + 16 * ks);
#pragma unroll
        for (int eb = 0; eb < 2; ++eb) { const bf16x8 B = *(const bf16x8*)(VB + (32 * eb) * 136 + 16 * ks); C[eb] = MFMA32(A, B, C[eb]); } }
    float* o = KV + (size_t)dir * NB * NCH * 4 * 2048 + ((size_t)(b * NCH + np) * 4 + h) * 2048 + r;
#pragma unroll
    for (int eb = 0; eb < 2; ++eb)
#pragma unroll
        for (int i = 0; i < 16; ++i) o[((i & 3) + 8 * (i >> 2) + 4 * hh) * 64 + 32 * eb] = C[eb][i];
}

DI void ret_scan_task(float* KV, const float* dec_f, const float* dec_b, int t, int lane) {
    const int b = t >> 6, rem = t & 63, h = rem >> 4, dir = (rem >> 3) & 1, dq = rem & 7;
    const float cdec = exp2f(ret_l2g(dir ? dec_b : dec_f, h) * 128.f);
    const size_t base = (size_t)dir * NB * NCH * 4 * 2048 + ((size_t)(b * NCH) * 4 + h) * 2048 + (size_t)(4 * dq) * 64 + lane;
    const float* src = KV + base; float* dst = KV + (size_t)2 * NB * NCH * 4 * 2048 + base;
    float v[18][4];
#pragma unroll
    for (int k = 0; k < 18; ++k) { const int m = dir ? (k == 0 ? 1 : (k == 1 ? 0 : 19 - k)) : k;
#pragma unroll
        for (int dd = 0; dd < 4; ++dd) v[k][dd] = src[(size_t)m * 4 * 2048 + dd * 64]; }
    float sst[4] = {0.f, 0.f, 0.f, 0.f};
#pragma unroll
    for (int k = 0; k < 18; ++k) { const int m = dir ? (k == 0 ? 1 : (k == 1 ? 0 : 19 - k)) : k;
#pragma unroll
        for (int dd = 0; dd < 4; ++dd) { dst[(size_t)m * 4 * 2048 + dd * 64] = sst[dd]; sst[dd] = cdec * sst[dd] + v[k][dd]; } }
}

DI void retout_mfma_item(const bf16* P, const float* KV, bf16* MIXO, const float* dec_f, const float* dec_b, const float* g_ret, unsigned char* lds, int b, int np) {
    const int tid = otid(), lane = tid & 63, w = tid >> 6, r = lane & 31, hh = lane >> 5;
    bf16* VT = (bf16*)lds; bf16* STT = VT + 4 * 64 * 136; float* ssq = (float*)(STT + 8 * 64 * 40);
    const int rowbase = ret_rowbase(b, np);
    __syncthreads();
    ret_stage_vt(P, rowbase, VT, tid);
    {
        const int h = w & 3, dir = w >> 2;
        float sreg[32];
        const float* src = KV + (size_t)(2 + dir) * NB * NCH * 4 * 2048 + ((size_t)(b * NCH + np) * 4 + h) * 2048 + lane;
#pragma unroll
        for (int d = 0; d < 32; ++d) sreg[d] = src[d * 64];
        bf16* sd = STT + (w * 64 + lane) * 40;
#pragma unroll
        for (int d4 = 0; d4 < 4; ++d4) { v4u o; o.x = pk2(sreg[8 * d4], sreg[8 * d4 + 1]); o.y = pk2(sreg[8 * d4 + 2], sreg[8 * d4 + 3]); o.z = pk2(sreg[8 * d4 + 4], sreg[8 * d4 + 5]); o.w = pk2(sreg[8 * d4 + 6], sreg[8 * d4 + 7]);
            *(v4u*)(sd + 8 * d4) = o; }
    }
    __syncthreads();
    const int h = w & 3, qh = w >> 2;
    const float l2f = ret_l2g(dec_f, h), l2b = ret_l2g(dec_b, h);
    bf16x8 Qf[2][2];
#pragma unroll
    for (int qb = 0; qb < 2; ++qb)
#pragma unroll
        for (int s = 0; s < 2; ++s) Qf[qb][s] = *(const bf16x8*)(P + (size_t)(rowbase + 64 * qh + 32 * qb + r) * DIN + C_RQ + 32 * h + 16 * s + 8 * hh);
    float cf1[4], cf8[4], cb1[4], cb8[4];
#pragma unroll
    for (int i = 0; i < 4; ++i) { cf1[i] = exp2f(-l2f * (float)i); cf8[i] = exp2f(-l2f * (float)(8 * i + 4 * hh)); cb1[i] = exp2f(l2b * (float)i); cb8[i] = exp2f(l2b * (float)(8 * i + 4 * hh)); }
    f32x16 O[2][2];
#pragma unroll
    for (int qb = 0; qb < 2; ++qb)
#pragma unroll
        for (int eb = 0; eb < 2; ++eb)
#pragma unroll
            for (int i = 0; i < 16; ++i) O[qb][eb][i] = 0.f;
#pragma unroll 1
    for (int jb = 0; jb < 4; ++jb) {
        bf16x8 Kf[2];
#pragma unroll
        for (int s = 0; s < 2; ++s) Kf[s] = *(const bf16x8*)(P + (size_t)(rowbase + 32 * jb + r) * DIN + C_RK + 32 * h + 16 * s + 8 * hh);
        bf16x8 Vf[2][2];
#pragma unroll
        for (int eb = 0; eb < 2; ++eb)
#pragma unroll
            for (int u = 0; u < 2; ++u) { const bf16* vp = VT + (h * 64 + 32 * eb + r) * 136 + 32 * jb + 16 * u + 4 * hh;
                const s16x4 lo = *(const s16x4*)vp, hi = *(const s16x4*)(vp + 8); Vf[eb][u] = __builtin_shufflevector(lo, hi, 0, 1, 2, 3, 4, 5, 6, 7); }
#pragma unroll
        for (int qb = 0; qb < 2; ++qb) {
            f32x16 S;
#pragma unroll
            for (int i = 0; i < 16; ++i) S[i] = 0.f;
#pragma unroll
            for (int s = 0; s < 2; ++s) S = MFMA32(Kf[s], Qf[qb][s], S);
            const int qbg = 2 * qh + qb; const float iloc = (float)(32 * qbg + r);
            if (jb < qbg) { const float rf = exp2f(l2f * (iloc - (float)(32 * jb)));
#pragma unroll
                for (int i4 = 0; i4 < 4; ++i4) { const float r8 = rf * cf8[i4];
#pragma unroll
                    for (int i = 0; i < 4; ++i) S[4 * i4 + i] *= r8 * cf1[i]; } }
            else if (jb > qbg) { const float rb = exp2f(l2b * ((float)(32 * jb) - iloc));
#pragma unroll
                for (int i4 = 0; i4 < 4; ++i4) { const float r8 = rb * cb8[i4];
#pragma unroll
                    for (int i = 0; i < 4; ++i) S[4 * i4 + i] *= r8 * cb1[i]; } }
            else {
#pragma unroll
                for (int i = 0; i < 16; ++i) { const int diff = r - ((i & 3) + 8 * (i >> 2) + 4 * hh); float wgt = 0.f;
                    if (diff >= 0) wgt += exp2f(l2f * (float)diff);
                    if (diff <= 0) wgt += exp2f(-l2b * (float)diff);
                    S[i] *= wgt; } }
            bf16x8 Pf[2];
#pragma unroll
            for (int u = 0; u < 2; ++u) { v4u pw; pw.x = pk2(S[8 * u + 0], S[8 * u + 1]); pw.y = pk2(S[8 * u + 2], S[8 * u + 3]); pw.z = pk2(S[8 * u + 4], S[8 * u + 5]); pw.w = pk2(S[8 * u + 6], S[8 * u + 7]);
                Pf[u] = __builtin_bit_cast(bf16x8, pw); }
#pragma unroll
            for (int eb = 0; eb < 2; ++eb)
#pragma unroll
                for (int u = 0; u < 2; ++u) O[qb][eb] = MFMA32(Vf[eb][u], Pf[u], O[qb][eb]);
        }
    }
#pragma unroll
    for (int dir = 0; dir < 2; ++dir)
#pragma unroll
        for (int eb = 0; eb < 2; ++eb) {
            bf16x8 Sf[2];
#pragma unroll
            for (int s = 0; s < 2; ++s) Sf[s] = *(const bf16x8*)(STT + ((dir * 4 + h) * 64 + 32 * eb + r) * 40 + 16 * s + 8 * hh);
#pragma unroll
            for (int qb = 0; qb < 2; ++qb) { f32x16 X;
#pragma unroll
                for (int i = 0; i < 16; ++i) X[i] = 0.f;
#pragma unroll
                for (int s = 0; s < 2; ++s) X = MFMA32(Sf[s], Qf[qb][s], X);
                const float iloc = (float)(64 * qh + 32 * qb + r);
                const float fac = dir ? exp2f(l2b * (128.f - iloc)) : exp2f(l2f * (iloc + 1.f));
#pragma unroll
                for (int i = 0; i < 16; ++i) O[qb][eb][i] += fac * X[i]; }
        }
#pragma unroll
    for (int qb = 0; qb < 2; ++qb) {
        float ss = 0.f;
#pragma unroll
        for (int eb = 0; eb < 2; ++eb)
#pragma unroll
            for (int i = 0; i < 16; ++i) ss += O[qb][eb][i] * O[qb][eb][i];
        ss += __shfl_xor(ss, 32);
        const float rinv = 1.0f / sqrtf(ss * (1.0f / 64.0f) + EPSN);
        const bf16* grow = P + (size_t)(rowbase + 64 * qh + 32 * qb + r) * DIN + C_RG + 64 * h;
        float s2 = 0.f;
#pragma unroll
        for (int eb = 0; eb < 2; ++eb)
#pragma unroll
            for (int i4 = 0; i4 < 4; ++i4) { const v2u gq = *(const v2u*)(grow + 32 * eb + 8 * i4 + 4 * hh);
                const float g0 = bflo(gq.x), g1 = bfhi(gq.x), g2 = bflo(gq.y), g3 = bfhi(gq.y);
                O[qb][eb][4 * i4 + 0] *= rinv * g0; O[qb][eb][4 * i4 + 1] *= rinv * g1; O[qb][eb][4 * i4 + 2] *= rinv * g2; O[qb][eb][4 * i4 + 3] *= rinv * g3;
                s2 += O[qb][eb][4 * i4 + 0] * O[qb][eb][4 * i4 + 0] + O[qb][eb][4 * i4 + 1] * O[qb][eb][4 * i4 + 1] + O[qb][eb][4 * i4 + 2] * O[qb][eb][4 * i4 + 2] + O[qb][eb][4 * i4 + 3] * O[qb][eb][4 * i4 + 3]; }
        s2 += __shfl_xor(s2, 32);
        if (hh == 0) ssq[h * 128 + 64 * qh + 32 * qb + r] = s2;
    }
    __syncthreads();
#pragma unroll
    for (int qb = 0; qb < 2; ++qb) { const int il = 64 * qh + 32 * qb + r;
        const float tot = ssq[il] + ssq[128 + il] + ssq[256 + il] + ssq[384 + il];
        const float rinv = 1.0f / sqrtf(tot * (1.0f / 256.0f) + EPSN);
        bf16* orow = MIXO + (size_t)(rowbase + il) * DM + 64 * h;
#pragma unroll
        for (int eb = 0; eb < 2; ++eb)
#pragma unroll
            for (int i4 = 0; i4 < 4; ++i4) { const int e = 32 * eb + 8 * i4 + 4 * hh; const f32x4 gg = *(const f32x4*)(g_ret + 64 * h + e);
                v2u o; o.x = pk2(O[qb][eb][4 * i4 + 0] * rinv * gg.x, O[qb][eb][4 * i4 + 1] * rinv * gg.y); o.y = pk2(O[qb][eb][4 * i4 + 2] * rinv * gg.z, O[qb][eb][4 * i4 + 3] * rinv * gg.w);
                *(v2u*)(orow + e) = o; }
    }
}

#define LAS __attribute__((address_space(3)))
#define XB_TMO      128
#define XB_XCNT(j)  (256  + 64 * (j))
#define XB_XSUB(j)  (1280 + 64 * (j))
#define XB_XGEN(j)  (2304 + 64 * (j))
#define XB_TOP      3328
#define XB_TOPGEN   3392
#define XCD_BAR_WORDS 3456
#define XB_SPIN_CAP (1u << 18)

__device__ __forceinline__ unsigned xb_ld(unsigned* p)              { return __hip_atomic_load(p, __ATOMIC_RELAXED, __HIP_MEMORY_SCOPE_AGENT); }
__device__ __forceinline__ unsigned xb_add(unsigned* p, unsigned v) { return __hip_atomic_fetch_add(p, v, __ATOMIC_RELAXED, __HIP_MEMORY_SCOPE_AGENT); }
__device__ __forceinline__ unsigned xb_xcc_id() { return (unsigned)__builtin_amdgcn_s_getreg((3 << 11) | 20) & 0xFu; }
#define XB_SPIN(cond, bar) do { unsigned _sp = 0; while (cond) { __builtin_amdgcn_s_sleep(1); \
    if ((++_sp & 255u) == 0u) { if (xb_ld(&(bar)[XB_TMO])) break; if (_sp > XB_SPIN_CAP) { atomicAdd(&(bar)[XB_TMO], 1u); break; } } } } while (0)

struct XcdBarrier {
    unsigned* bar; unsigned x;
    volatile LAS unsigned* st;
};

__device__ __forceinline__ XcdBarrier xcd_barrier_post(unsigned* bar, volatile LAS unsigned* st) {
    XcdBarrier b; b.bar = bar; b.x = xb_xcc_id(); b.st = st;
    if (threadIdx.x == 0) (void)xb_add(&bar[XB_XCNT(b.x)], 1u);
    return b;
}
__device__ __forceinline__ void xcd_barrier_complete(unsigned* bar, unsigned x, unsigned& nloc, unsigned& nx) {
    const unsigned G = gridDim.x * gridDim.y * gridDim.z;
    unsigned sum, cnt, mine, sp = 0u;
    for (;;) {
        sum = 0u; cnt = 0u; mine = 0u;
#pragma unroll
        for (unsigned j = 0; j < 16; ++j) { const unsigned c = xb_ld(&bar[XB_XCNT(j)]); sum += c; cnt += (c > 0u) ? 1u : 0u; mine = (j == x) ? c : mine; }
        if (sum == G) break;
        __builtin_amdgcn_s_sleep(1);
        if ((++sp & 255u) == 0u) { if (xb_ld(&bar[XB_TMO])) break; if (sp > XB_SPIN_CAP) { atomicAdd(&bar[XB_TMO], 1u); break; } }
    }
    nloc = mine > 0u ? mine : 1u; nx = cnt > 0u ? cnt : 1u;
}

__device__ __forceinline__ void xcd_barrier(const XcdBarrier& b) {
    asm volatile("s_waitcnt vmcnt(0)" ::: "memory");
    __syncthreads();
    if (threadIdx.x == 0) {
        unsigned* bar = b.bar; const unsigned bx = xb_xcc_id();
        __builtin_amdgcn_s_waitcnt(0);
        unsigned nloc = b.st[0], nx = b.st[1];
        if (nloc == 0u) { xcd_barrier_complete(bar, bx, nloc, nx); b.st[0] = nloc; b.st[1] = nx; }
        const unsigned old = xb_add(&bar[XB_XSUB(bx)], 1u);
        const unsigned gen = old / nloc;
        if (old + 1u == (gen + 1u) * nloc) {
            __builtin_amdgcn_fence(__ATOMIC_RELEASE, "agent");
            asm volatile("s_waitcnt vmcnt(0)" ::: "memory");
            const unsigned og = xb_add(&bar[XB_TOP], 1u);
            const unsigned tg = og / nx;
            if (og + 1u == (tg + 1u) * nx) xb_add(&bar[XB_TOPGEN], 1u);
            else XB_SPIN(xb_ld(&bar[XB_TOPGEN]) == tg, bar);
            __builtin_amdgcn_fence(__ATOMIC_ACQUIRE, "agent");
            xb_add(&bar[XB_XGEN(bx)], 1u);
            asm volatile("s_waitcnt vmcnt(0)" ::: "memory");
        } else {
            XB_SPIN(xb_ld(&bar[XB_XGEN(bx)]) == gen, bar);
            __builtin_amdgcn_fence(__ATOMIC_ACQUIRE, "agent");
            asm volatile("s_waitcnt vmcnt(0)" ::: "memory");
        }
    }
    __syncthreads();
}


__global__ void __launch_bounds__(512, 2) mega_fwd(Args a) {
    extern __shared__ __attribute__((aligned(16))) unsigned char lds[];
    cg::grid_group grid = cg::this_grid();
    volatile LAS unsigned* xst = (volatile LAS unsigned*)(lds + LDS_BYTES - 16);
    if (threadIdx.x < 2) xst[threadIdx.x] = 0u;
    if (blockIdx.x == 0) { for (int i = threadIdx.x; i < XCD_BAR_WORDS; i += 512) ((unsigned*)a.ws)[i] = 0u; }
    __syncthreads();
#define GSYNC() xcd_barrier(xbar)
    const int bid = blockIdx.x, G = gridDim.x;
    unsigned char* ws = a.ws;
    bf16* const P = (bf16*)(ws + WS_P); bf16* const MIXO = (bf16*)(ws + WS_MIXO); bf16* const YH = (bf16*)(ws + WS_YH); bf16* const U = (bf16*)(ws + WS_U);
    bf16* const XB = (bf16*)(ws + WS_XB); float* const KV = (float*)(ws + WS_KV); const float* const ADA = (const float*)(ws + WS_ADA);
    unsigned char* const ob = (unsigned char*)a.out;
    bf16* const ZT = (bf16*)(ob + OUT_ZT); bf16* const ZTC = (bf16*)(ob + OUT_ZTC); bf16* const YT = (bf16*)(ob + OUT_YT); bf16* const YTC = (bf16*)(ob + OUT_YTC);

    p0_prologue(a, lds, bid, G);
    grid.sync();
    const XcdBarrier xbar = xcd_barrier_post((unsigned*)a.ws, xst);
    ew_phase(a.in[0], a.in[2], nullptr, nullptr, nullptr, nullptr, nullptr, nullptr, 0, nullptr, YH, ADA, 0, 1024, a.in[6], TT, bid, G);
    GSYNC();

#pragma unroll 1
    for (int l = 0; l < DEPTH; ++l) {
        const bool last = (l == DEPTH - 1);
        const unsigned char* wl = ws + WS_W + (size_t)l * W_LAYER;
        const float* ada_l = ADA + (size_t)l * 33 * 6144;
        const int Mo = last ? TL : TT;
        { pg8::Gemm g{(const pg8::bf16_t*)YH, (const pg8::bf16_t*)(wl + WO_IN), TT, DIN, DM}; pg8::StaticOrder S; S.init(TT, DIN, G, bid);
          pg8::EpiWin E{(pg8::bf16_t*)P, (const float*)(ws + WS_ROTR), (const float*)(ws + WS_ROTA)};
          pg8::gemm_phase<pg8::EpiWin, pg8::StaticOrder, true, true>((PG8_LAS unsigned char*)lds, g, S, E); }
        GSYNC();
        {
            const int nA = 1024 + (last ? 0 : 128), nH = 1024 + (last ? 0 : 128), nR = NB * NCH;
            const float* sw = a.in[13] + (size_t)l * 3 * 768; const float* sbias = a.in[14] + l * 768;
            const int vb = (G & 7) == 0 ? (bid & 7) * (G >> 3) + (bid >> 3) : bid;
            for (int it = vb; it < nA + nH + nR; it += G) {
                if (it < nA) {
                    if (it < 1024) { const int b = 31 - (it >> 5), qb = it & 31; attn_item(P, MIXO, a.in[22] + l * 8, a.in[25] + l * 512, lds, b * SEQ + 64 * qb, 64 * qb, b * SEQ, TL + b * LC, false); }
                    else { const int j = it - 1024, b = j >> 2, qb = j & 3; attn_item(P, MIXO, a.in[22] + l * 8, a.in[25] + l * 512, lds, TL + b * LC + 64 * qb, 0, b * SEQ, TL + b * LC, true); }
                } else if (it < nA + nH) {
                    const int j = it - nA;
                    if (j < 1024) { const int b = 31 - (j >> 5), tb = j & 31; hypre_item(P, sw, sbias, ZT, lds, b * SEQ, b, 64 * tb, SEQ); }
                    else { const int jj = j - 1024, b = jj >> 2, tb = jj & 3; hypre_item(P, sw, sbias, ZTC, lds, TL + b * LC, b, 64 * tb, LC); }
                } else {
                    const int j = it - nA - nH; retkv_mfma_item(P, KV, a.in[11] + l * 4, a.in[12] + l * 4, lds, 31 - j / NCH, j % NCH);
                }
            }
        }
        GSYNC();
        {
            {
            { const int tq = otid(); for (int t = bid * 8 + (tq >> 6); t < NB * 64; t += G * 8) ret_scan_task(KV, a.in[11] + l * 4, a.in[12] + l * 4, t, tq & 63); }
            const int nC = 256, nCc = last ? 0 : 256;
            for (int it = bid; it < nC + nCc; it += G) {
                if (it < nC) hyconv_item<SEQ>(ZT + (size_t)it * 32 * SEQ, (const bf16*)(ws + WS_RF) + ((size_t)l * 256 + it) * 4096, YT + (size_t)it * 32 * SEQ, lds);
                else { const int c = it - nC; hyconv_item<LC>(ZTC + (size_t)c * 32 * LC, (const bf16*)(ws + WS_RC) + ((size_t)l * 256 + c) * 512, YTC + (size_t)c * 32 * LC, lds); }
            } }
        }
        GSYNC();
        {
            const int nRo = NB * (last ? 16 : 18), nH = 1024 + (last ? 0 : 128);
            const float* sw = a.in[13] + (size_t)l * 3 * 768; const float* sbias = a.in[14] + l * 768;
            for (int it = bid; it < nRo + nH; it += G) {
                if (it < nRo) { int b, np; if (last) { b = it >> 4; np = 2 + (it & 15); } else { b = it / 18; np = it % 18; }
                    retout_mfma_item(P, KV, MIXO, a.in[11] + l * 4, a.in[12] + l * 4, a.in[23] + l * 256, lds, b, np); }
                else { const int j = it - nRo;
                    if (j < 1024) { const int b = j >> 5, tb = j & 31; hypost_item(P, sw, sbias, a.in[21] + l * 256, a.in[24] + l * 256, YT, MIXO, lds, b * SEQ, b, 64 * tb, SEQ); }
                    else { const int jj = j - 1024, b = jj >> 2, tb = jj & 3; hypost_item(P, sw, sbias, a.in[21] + l * 256, a.in[24] + l * 256, YTC, MIXO, lds, TL + b * LC, b, 64 * tb, LC); } }
            }
        }
        GSYNC();
        { pg8::Gemm g{(const pg8::bf16_t*)MIXO, (const pg8::bf16_t*)(wl + WO_OUT), Mo, DM, DM}; pg8::StaticOrder S; S.init(Mo, DM, G, bid);
          pg8::EpiBf16<0> E{(pg8::bf16_t*)YH, DM};
          pg8::gemm_phase<pg8::EpiBf16<0>, pg8::StaticOrder, true, true>((PG8_LAS unsigned char*)lds, g, S, E); }
        GSYNC();
        ew_phase(a.in[0], a.in[2], l == 0 ? nullptr : XB, a.out, nullptr, last ? nullptr : XB, YH, ada_l, 2048, a.in[7] + l * DM, YH, ada_l, 3072, 4096, a.in[8] + l * DM, Mo, bid, G);
        GSYNC();
        { pg8::Gemm g{(const pg8::bf16_t*)YH, (const pg8::bf16_t*)(wl + WO_1), Mo, DFF, DM}; pg8::StaticOrder S; S.init(Mo, DFF, G, bid);
          pg8::EpiBf16<1> E{(pg8::bf16_t*)U, DFF};
          pg8::gemm_phase<pg8::EpiBf16<1>, pg8::StaticOrder, true, true>((PG8_LAS unsigned char*)lds, g, S, E); }
        GSYNC();
        { pg8::Gemm g{(const pg8::bf16_t*)U, (const pg8::bf16_t*)(wl + WO_2), Mo, DM, DFF}; pg8::RevOrder S; S.init(Mo, DM, G, bid);
          pg8::EpiBf16<0> E{(pg8::bf16_t*)YH, DM};
          pg8::gemm_phase<pg8::EpiBf16<0>, pg8::RevOrder, true, true>((PG8_LAS unsigned char*)lds, g, S, E); }
        GSYNC();
        ew_phase(a.out, nullptr, last ? nullptr : XB, a.out, nullptr, last ? nullptr : XB, YH, ada_l, 5120, a.in[9] + l * DM, last ? nullptr : YH, ada_l + 33 * 6144, 0, 1024, a.in[6] + (last ? 0 : (l + 1) * DM), Mo, bid, G);
        if (!last) GSYNC();
    }
}

extern "C" void kernel_launch(void* const* d_in, const int* in_sizes, int n_in, void* d_out, int out_size, void* d_ws, size_t ws_size, hipStream_t stream) {
    static int grid = 0;
    if (grid == 0) {
        if (n_in != 29 || out_size != TL * DM || ws_size < WS_END) { fprintf(stderr, "kernel_launch: unexpected shapes (n_in %d out %d ws %zu)\n", n_in, out_size, ws_size); grid = -1; return; }
        int dev = 0, cus = 0, per_cu = 0;
        hipGetDevice(&dev); hipDeviceGetAttribute(&cus, hipDeviceAttributeMultiprocessorCount, dev);
        if (hipFuncSetAttribute((const void*)mega_fwd, hipFuncAttributeMaxDynamicSharedMemorySize, LDS_BYTES) != hipSuccess) { fprintf(stderr, "kernel_launch: hipFuncSetAttribute failed\n"); grid = -1; return; }
        if (hipOccupancyMaxActiveBlocksPerMultiprocessor(&per_cu, (const void*)mega_fwd, 512, LDS_BYTES) != hipSuccess || per_cu < 1) { fprintf(stderr, "kernel_launch: occupancy query failed (%d)\n", per_cu); per_cu = 1; }
        (void)hipGetLastError();
        grid = cus * per_cu;
    }
    if (grid < 0) return;
    Args a{};
    for (int i = 0; i < 29; ++i) a.in[i] = (const float*)d_in[i];
    a.out = (float*)d_out; a.ws = (unsigned char*)d_ws;
    void* args[] = {&a};
    hipError_t e = hipLaunchCooperativeKernel((const void*)mega_fwd, dim3(grid), dim3(512), args, LDS_BYTES, stream);
    if (e != hipSuccess) fprintf(stderr, "kernel_launch: cooperative launch failed: %s (grid %d)\n", hipGetErrorString(e), grid);
}
```

```cpp
#include <hip/hip_runtime.h>
#include <hip/hip_cooperative_groups.h>
#include <cstdio>
#include <cstdint>
namespace cg = cooperative_groups;
#include <hip/hip_runtime.h>
namespace pg8 {
#define PG8_LAS __attribute__((address_space(3)))
typedef unsigned short bf16_t;
typedef short bf16x8 __attribute__((ext_vector_type(8)));
typedef float f32x4 __attribute__((ext_vector_type(4)));
typedef unsigned u32x4 __attribute__((ext_vector_type(4)));
constexpr int BM = 256, BK = 64, HALF = 128, HTB = HALF * BK * 2  , STAGE_BYTES = 8 * HTB, NXCD = 8, WGM = 8;

__host__ __device__ __forceinline__ int lds_byte(int r, int c) { const int st = (r >> 4) * 2 + (c >> 5), rr = r & 15, cc = c & 31, ob = rr * 64 + cc * 2; return st * 1024 + (ob ^ (((ob >> 9) & 1) << 5)); }
__host__ __device__ __forceinline__ void stage_rc(int b, int& R, int& C) { const int st = b / 1024, sb = b % 1024, swz = sb ^ (((sb >> 9) & 1) << 5); R = (st >> 1) * 16 + swz / 64; C = (st & 1) * 32 + (swz % 64) / 2; }
__host__ __device__ __forceinline__ int perm32(int rho) { const int n = rho >> 4, i = rho & 15; return 8 * (i >> 2) + 4 * n + (i & 3); }

struct Unit { int pm, pn; };
struct Gemm { const bf16_t* A; const bf16_t* Bt; int M, N, K; };

struct StaticOrder {
    int nM, nN, nwg, G, c;
    __host__ __device__ void init(int M, int N, int G_, int c_) { nM = M / BM; nN = N / BM; nwg = nM * nN; G = G_; c = c_; }
    __host__ __device__ bool next(int i, Unit& u) const {
        const long L = (long)i * G + c; if (L >= nwg) return false;
        int wgid = (int)L; { const int q = nwg / NXCD, r = nwg % NXCD, xcd = wgid % NXCD, off = wgid / NXCD; wgid = (xcd < r ? xcd * (q + 1) : r * (q + 1) + (xcd - r) * q) + off; }
        const int nig = WGM * nN, gid = wgid / nig, fm = gid * WGM, gsz = (nM - fm) < WGM ? (nM - fm) : WGM;
        u.pm = fm + ((wgid % nig) % gsz); u.pn = (wgid % nig) / gsz; return true;
    }
    __device__ __forceinline__ void a_ready(const Unit&) const {}
    __device__ __forceinline__ void done(const Unit&) const {}
};

struct RevOrder : StaticOrder {
    __host__ __device__ bool next(int i, Unit& u) const { if (!StaticOrder::next(i, u)) return false; u.pm = nM - 1 - u.pm; return true; }
};
__device__ __forceinline__ unsigned cvt_pk_bf16(float lo, float hi) { unsigned r; asm volatile("v_cvt_pk_bf16_f32 %0, %1, %2" : "=v"(r) : "v"(lo), "v"(hi)); return r; }
typedef unsigned u32x2 __attribute__((ext_vector_type(2)));

template <int ACT  > struct EpiBf16 {
    static constexpr bool PERM = true, AFTER_DRAIN = false;
    bf16_t* O; int ldc;
    __device__ __forceinline__ void operator()(const f32x4 (&acc)[2][2][4][2], const Unit& u, int wr, int wc, int fr, int fq) const {
        const int row0 = u.pm * BM + wr * 64 + fr; const int col0 = u.pn * BM + wc * 32 + 8 * fq;
#pragma unroll
        for (int ai = 0; ai < 2; ++ai)
#pragma unroll
            for (int m = 0; m < 4; ++m) { bf16_t* rowp = O + (size_t)(row0 + ai * HALF + m * 16) * ldc + col0;
#pragma unroll
                for (int bj = 0; bj < 2; ++bj) { f32x4 v0 = acc[ai][bj][m][0], v1 = acc[ai][bj][m][1];
                    if (ACT == 1) {
#pragma unroll
                        for (int j = 0; j < 4; ++j) { const float a = fmaxf(v0[j], 0.f), b = fmaxf(v1[j], 0.f); v0[j] = a * a; v1[j] = b * b; } }
                    u32x4 w; w.x = cvt_pk_bf16(v0[0], v0[1]); w.y = cvt_pk_bf16(v0[2], v0[3]); w.z = cvt_pk_bf16(v1[0], v1[1]); w.w = cvt_pk_bf16(v1[2], v1[3]);
                    *(u32x4*)(rowp + bj * HALF) = w; } }
    }
};

struct EpiWin {
    static constexpr bool PERM = false, AFTER_DRAIN = false;
    bf16_t* P; const float* rot_ret; const float* rot_ax;
    __device__ __forceinline__ void operator()(const f32x4 (&acc)[2][2][4][2], const Unit& u, int wr, int wc, int fr, int fq) const {
        const int row0 = u.pm * BM + wr * 64 + fr; const bool latent = (u.pm < 256); const int pn = u.pn;
#pragma unroll
        for (int ai = 0; ai < 2; ++ai)
#pragma unroll
            for (int m = 0; m < 4; ++m) { const int row = row0 + ai * HALF + m * 16; const int pos = row & 2047;
                bf16_t* rowp = P + (size_t)row * 2304 + pn * BM + wc * 32 + 4 * fq;
#pragma unroll
                for (int bj = 0; bj < 2; ++bj) { f32x4 v0 = acc[ai][bj][m][0], v1 = acc[ai][bj][m][1];
                    int mode = 0; float post = 1.f; const float* tab = rot_ret;
                    if (pn == 0) { mode = latent ? 1 : 0; tab = rot_ret + pos * 32 + 4 * fq; if (bj == 1) post = 0.17677669529663687f; }
                    else if (pn == 2) mode = 2;
                    else if (pn == 6 || pn == 7) { mode = latent ? 1 : 0; tab = rot_ax + pos * 64 + (wc & 1) * 32 + 4 * fq; post = 0.125f * 1.4426950408889634f; }
                    else if (pn == 8 && bj == 0) { mode = latent ? 1 : 0; tab = rot_ax + pos * 64 + (wc & 1) * 32 + 4 * fq; }
                    if (mode == 1) { const f32x4 c = *(const f32x4*)tab, s = *(const f32x4*)(tab + 16);
                        const f32x4 o0 = v0 * c - v1 * s, o1 = v1 * c + v0 * s; v0 = o0; v1 = o1; }
                    if (mode == 2) {
#pragma unroll
                        for (int j = 0; j < 4; ++j) { v0[j] = v0[j] / (1.f + __expf(-v0[j])); v1[j] = v1[j] / (1.f + __expf(-v1[j])); } }
                    v0 = v0 * post; v1 = v1 * post;
                    u32x2 w0, w1; w0.x = cvt_pk_bf16(v0[0], v0[1]); w0.y = cvt_pk_bf16(v0[2], v0[3]); w1.x = cvt_pk_bf16(v1[0], v1[1]); w1.y = cvt_pk_bf16(v1[2], v1[3]);
                    *(u32x2*)(rowp + bj * HALF) = w0; *(u32x2*)(rowp + bj * HALF + 16) = w1; } }
    }
};

template <class Epi, class Sched, bool ALIGN_EPI = false, bool SP2 = false>
__device__ __forceinline__ void gemm_phase(PG8_LAS unsigned char* lds, const Gemm g, const Sched& S, const Epi& E) {
    int tid_ = threadIdx.x; asm volatile("" : "+v"(tid_));
    const int tid = tid_, wid = __builtin_amdgcn_readfirstlane(tid >> 6), lane = tid & 63, wr = wid >> 2, wc = wid & 3, fr = lane & 15, fq = lane >> 4;
    const int K = g.K, nt = K / BK;
    unsigned voffA[2], voffB[2];
#pragma unroll
    for (int i = 0; i < 2; ++i) { int R, C; stage_rc(tid * 16 + i * 8192, R, C); const int Rb = Epi::PERM ? ((R & ~31) + perm32(R & 31)) : R;
        voffA[i] = (unsigned)(R * K + C) * 2u; voffB[i] = (unsigned)(Rb * K + C) * 2u; }
    const size_t kstep = (size_t)(BK * 2);
    const size_t hstep = (size_t)HALF * K * 2;
    const size_t tstep = 2 * hstep;
    const unsigned ldsw = (unsigned)wid * 1024u;
    const int aoff = lds_byte(wr * 64 + fr, fq * 8), boff = lds_byte(wc * 32 + fr, fq * 8);
#define PG8_SA(b, h) (((b) * 2 + (h)) * HTB)
#define PG8_SB(b, h) ((4 + (b) * 2 + (h)) * HTB)
#define PG8_STAGE(bufoff, gbase, voff) do { _Pragma("unroll") for (int _i = 0; _i < 2; ++_i) \
        __builtin_amdgcn_global_load_lds((const unsigned*)((const char*)(gbase) + (voff)[_i]), (PG8_LAS unsigned*)(lds + (bufoff) + ldsw + _i * 8192), 16, 0, 0); } while (0)
#define PG8_LDA(dst, b, h) do { _Pragma("unroll") for (int m = 0; m < 4; ++m) _Pragma("unroll") for (int k = 0; k < 2; ++k) dst[m][k] = *(const PG8_LAS bf16x8*)(lds + PG8_SA(b, h) + aoff + m * 2048 + k * 1024); } while (0)
#define PG8_LDB(dst, b, h) do { _Pragma("unroll") for (int n = 0; n < 2; ++n) _Pragma("unroll") for (int k = 0; k < 2; ++k) dst[n][k] = *(const PG8_LAS bf16x8*)(lds + PG8_SB(b, h) + boff + n * 2048 + k * 1024); } while (0)
#define PG8_MMA(ai, bj, At, Bt) do { __builtin_amdgcn_s_setprio(1); _Pragma("unroll") for (int m = 0; m < 4; ++m) _Pragma("unroll") for (int n = 0; n < 2; ++n) _Pragma("unroll") for (int k = 0; k < 2; ++k) \
        acc[ai][bj][m][n] = __builtin_amdgcn_mfma_f32_16x16x32_bf16(Bt[n][k], At[m][k], acc[ai][bj][m][n], 0, 0, 0); __builtin_amdgcn_s_setprio(0); } while (0)
#define PG8_WAIT_V(n) asm volatile("s_waitcnt vmcnt(" #n ")" ::: "memory")
#define PG8_WAIT_L(n) asm volatile("s_waitcnt lgkmcnt(" #n ")" ::: "memory")
#define PG8_BAR __builtin_amdgcn_s_barrier()
#define PG8_SCHED __builtin_amdgcn_sched_barrier(0)
    Unit cur, nxt; int ui = 0;
    if (!S.next(0, cur)) return;
    f32x4 acc[2][2][4][2];
#pragma unroll
    for (int a = 0; a < 2; ++a)
#pragma unroll
        for (int b = 0; b < 2; ++b)
#pragma unroll
            for (int m = 0; m < 4; ++m)
#pragma unroll
                for (int n = 0; n < 2; ++n) acc[a][b][m][n] = (f32x4){0.f, 0.f, 0.f, 0.f};
    bf16x8 At[4][2], B0[2][2], B1[2][2];
    const char* cA = (const char*)g.A + (size_t)cur.pm * tstep; const char* cB = (const char*)g.Bt + (size_t)cur.pn * tstep;
    S.a_ready(cur);
    if constexpr (SP2) {
        PG8_STAGE(PG8_SB(0, 0), cB, voffB); PG8_STAGE(PG8_SB(0, 1), cB + hstep, voffB); PG8_STAGE(PG8_SA(0, 0), cA, voffA); PG8_STAGE(PG8_SA(0, 1), cA + hstep, voffA);
        if (wr == 1) PG8_BAR;
        PG8_WAIT_V(2); PG8_BAR;
        PG8_STAGE(PG8_SB(1, 0), cB + kstep, voffB); PG8_STAGE(PG8_SA(1, 0), cA + kstep, voffA); PG8_STAGE(PG8_SB(1, 1), cB + hstep + kstep, voffB);
        PG8_WAIT_V(6); PG8_BAR;
    } else {
        PG8_STAGE(PG8_SB(0, 0), cB, voffB); PG8_STAGE(PG8_SA(0, 0), cA, voffA); PG8_STAGE(PG8_SB(0, 1), cB + hstep, voffB); PG8_STAGE(PG8_SA(0, 1), cA + hstep, voffA);
        if (wr == 1) PG8_BAR;
        PG8_WAIT_V(4); PG8_BAR;
        PG8_STAGE(PG8_SB(1, 0), cB + kstep, voffB); PG8_STAGE(PG8_SA(1, 0), cA + kstep, voffA); PG8_STAGE(PG8_SB(1, 1), cB + hstep + kstep, voffB);
        PG8_WAIT_V(6); PG8_BAR;
    }
    for (;;) {
        const bool has_next = S.next(ui + 1, nxt);
        const char* nA = has_next ? (const char*)g.A + (size_t)nxt.pm * tstep : cA; const char* nB = has_next ? (const char*)g.Bt + (size_t)nxt.pn * tstep : cB;
        for (int t = 0; t < nt; t += 2) {
            const bool last = (t == nt - 2);
            const char* a1 = cA + (size_t)(t + 1) * kstep;
            const char* a2 = last ? nA : cA + (size_t)(t + 2) * kstep; const char* b2 = last ? nB : cB + (size_t)(t + 2) * kstep;
            const char* a3 = a2 + kstep; const char* b3 = b2 + kstep;
            if (last && has_next) S.a_ready(nxt);
            if constexpr (SP2) {
            PG8_LDB(B0, 0, 0); PG8_LDB(B1, 0, 1); PG8_SCHED; PG8_LDA(At, 0, 0); PG8_STAGE(PG8_SA(1, 1), a1 + hstep, voffA);
            PG8_WAIT_V(8); PG8_WAIT_L(0); PG8_BAR; PG8_MMA(0, 0, At, B0); PG8_MMA(0, 1, At, B1); PG8_BAR; PG8_SCHED;
            PG8_LDA(At, 0, 1); PG8_STAGE(PG8_SB(0, 0), b2, voffB); PG8_STAGE(PG8_SB(0, 1), b2 + hstep, voffB); PG8_STAGE(PG8_SA(0, 0), a2, voffA);
            PG8_WAIT_V(8); PG8_WAIT_L(0); PG8_BAR; PG8_MMA(1, 0, At, B0); PG8_MMA(1, 1, At, B1); PG8_BAR; PG8_SCHED;
            PG8_LDB(B0, 1, 0); PG8_LDB(B1, 1, 1); PG8_SCHED; PG8_LDA(At, 1, 0); PG8_STAGE(PG8_SA(0, 1), a2 + hstep, voffA);
            PG8_WAIT_V(8); PG8_WAIT_L(0); PG8_BAR; PG8_MMA(0, 0, At, B0); PG8_MMA(0, 1, At, B1); PG8_BAR; PG8_SCHED;
            PG8_LDA(At, 1, 1); PG8_STAGE(PG8_SB(1, 0), b3, voffB); PG8_STAGE(PG8_SB(1, 1), b3 + hstep, voffB); PG8_STAGE(PG8_SA(1, 0), a3, voffA);
            PG8_WAIT_V(8); PG8_WAIT_L(0); PG8_BAR; PG8_MMA(1, 0, At, B0); PG8_MMA(1, 1, At, B1); PG8_BAR; PG8_SCHED;
            } else {
            PG8_LDB(B0, 0, 0); PG8_SCHED; PG8_LDA(At, 0, 0); PG8_STAGE(PG8_SA(1, 1), a1 + hstep, voffA);
            PG8_WAIT_L(8); PG8_BAR; PG8_WAIT_L(0); PG8_MMA(0, 0, At, B0); PG8_BAR; PG8_SCHED;
            PG8_LDB(B1, 0, 1); PG8_STAGE(PG8_SB(0, 0), b2, voffB);
            PG8_BAR; PG8_WAIT_L(0); PG8_MMA(0, 1, At, B1); PG8_BAR;
            PG8_LDA(At, 0, 1); PG8_STAGE(PG8_SA(0, 0), a2, voffA);
            PG8_BAR; PG8_WAIT_L(0); PG8_MMA(1, 0, At, B0); PG8_BAR; PG8_SCHED;
            PG8_STAGE(PG8_SB(0, 1), b2 + hstep, voffB);
            PG8_WAIT_V(6); PG8_BAR; PG8_MMA(1, 1, At, B1); PG8_BAR;
            PG8_LDB(B0, 1, 0); PG8_SCHED; PG8_LDA(At, 1, 0); PG8_STAGE(PG8_SA(0, 1), a2 + hstep, voffA);
            PG8_WAIT_L(8); PG8_BAR; PG8_WAIT_L(0); PG8_MMA(0, 0, At, B0); PG8_BAR; PG8_SCHED;
            PG8_LDB(B1, 1, 1); PG8_STAGE(PG8_SB(1, 0), b3, voffB);
            PG8_BAR; PG8_WAIT_L(0); PG8_MMA(0, 1, At, B1); PG8_BAR;
            PG8_LDA(At, 1, 1); PG8_STAGE(PG8_SA(1, 0), a3, voffA);
            PG8_BAR; PG8_WAIT_L(0); PG8_MMA(1, 0, At, B0); PG8_BAR; PG8_SCHED;
            PG8_STAGE(PG8_SB(1, 1), b3 + hstep, voffB);
            PG8_WAIT_V(6); PG8_BAR; PG8_MMA(1, 1, At, B1); PG8_BAR;
            }
        }
        if constexpr (ALIGN_EPI) { if (wr == 0) PG8_BAR; }
        if constexpr (!Epi::AFTER_DRAIN) { E(acc, cur, wr, wc, fr, fq); S.done(cur); }
        if (!has_next) break;
#pragma unroll
        for (int a = 0; a < 2; ++a)
#pragma unroll
            for (int b = 0; b < 2; ++b)
#pragma unroll
                for (int m = 0; m < 4; ++m)
#pragma unroll
                    for (int n = 0; n < 2; ++n) acc[a][b][m][n] = (f32x4){0.f, 0.f, 0.f, 0.f};
        cur = nxt; cA = nA; cB = nB; ++ui;
        if constexpr (ALIGN_EPI) { if (wr == 1) PG8_BAR; }
    }
    PG8_WAIT_V(0);
    if constexpr (!ALIGN_EPI) { if (wr == 0) PG8_BAR; }
    PG8_BAR;
    if constexpr (Epi::AFTER_DRAIN) { E.fused(acc, cur, wr, wc, fr, fq, lds, wid, lane); S.done(cur); }
#undef PG8_SA
#undef PG8_SB
#undef PG8_STAGE
#undef PG8_LDA
#undef PG8_LDB
#undef PG8_MMA
#undef PG8_WAIT_V
#undef PG8_WAIT_L
#undef PG8_BAR
#undef PG8_SCHED
}
}
constexpr int DM = 1024, NB = 32, SEQ = 2048, DEPTH = 4, LC = 256;
constexpr int TL = NB * SEQ, TC = NB * LC, TT = TL + TC;
constexpr int DIN = 2304, DFF = 4096;
constexpr int C_RQ = 0, C_RK = 128, C_RV = 256, C_RG = 512, C_HY = 768, C_AQ = 1536, C_AK = 2048, C_AV = 2176;
constexpr float EPSN = 1e-6f, LOG2E = 1.4426950408889634f;
constexpr int NCH = 18;

constexpr size_t MiB = 1u << 20;
constexpr size_t WS_W = 2 * MiB, W_LAYER = (size_t)(2304 + 1024 + 4096 + 4096) * 1024 * 2;
constexpr size_t WO_IN = 0, WO_OUT = (size_t)2304 * 1024 * 2, WO_1 = WO_OUT + (size_t)1024 * 1024 * 2, WO_2 = WO_1 + (size_t)4096 * 1024 * 2;
constexpr size_t WS_ADA = 92 * MiB, WS_ROTR = 96 * MiB, WS_ROTA = 97 * MiB, WS_RF = 98 * MiB, WS_RC = 106 * MiB, WS_KV = 864 * MiB;
constexpr size_t OUT_ZT = 0 * MiB, OUT_ZTC = 32 * MiB, OUT_YT = 36 * MiB, OUT_YTC = 68 * MiB;
constexpr size_t WS_XB = 108 * MiB, WS_YH = 252 * MiB;
constexpr size_t WS_P = 396 * MiB, WS_MIXO = 720 * MiB, WS_U = 396 * MiB, WS_END = 972 * MiB;
constexpr int LDS_BYTES = 150 * 1024;

typedef unsigned short bf16;
typedef unsigned v4u __attribute__((ext_vector_type(4)));
typedef unsigned v2u __attribute__((ext_vector_type(2)));
typedef float f32x4 __attribute__((ext_vector_type(4)));
typedef float f32x16 __attribute__((ext_vector_type(16)));
typedef short bf16x8 __attribute__((ext_vector_type(8)));
typedef short s16x4 __attribute__((ext_vector_type(4)));
#define MFMA32(a, b, c) __builtin_amdgcn_mfma_f32_32x32x16_bf16((a), (b), (c), 0, 0, 0)
#define DI __device__ __forceinline__

DI unsigned f2bf(float f) { unsigned u = __builtin_bit_cast(unsigned, f); return (u + 0x7fffu + ((u >> 16) & 1u)) >> 16; }
typedef float f32x2_t __attribute__((ext_vector_type(2)));
typedef __bf16 bf16x2_t __attribute__((ext_vector_type(2)));
DI unsigned pk2(float lo, float hi) { const f32x2_t v = {lo, hi}; return __builtin_bit_cast(unsigned, __builtin_convertvector(v, bf16x2_t)); }
DI float bf2f(bf16 b) { return __builtin_bit_cast(float, (unsigned)b << 16); }
DI float bflo(unsigned w) { return __builtin_bit_cast(float, w << 16); }
DI float bfhi(unsigned w) { return __builtin_bit_cast(float, w & 0xffff0000u); }
template <int CTRL> DI float dpp_mov(float v) { return __builtin_bit_cast(float, __builtin_amdgcn_update_dpp(0, __builtin_bit_cast(int, v), CTRL, 0xf, 0xf, true)); }
DI float wave_sum(float v) {
    v += dpp_mov<0xB1>(v); v += dpp_mov<0x4E>(v); v += dpp_mov<0x141>(v); v += dpp_mov<0x140>(v);
    v += __shfl_xor(v, 16); v += __shfl_xor(v, 32);
    return v;
}
DI float rdlane(float v, int l) { return __builtin_bit_cast(float, __builtin_amdgcn_readlane(__builtin_bit_cast(int, v), l)); }

DI int otid() { int t = threadIdx.x; asm volatile("" : "+v"(t)); return t; }
DI size_t ozero() { size_t z = 0; asm volatile("" : "+s"(z)); return z; }
DI unsigned ozero32() { unsigned z = 0; asm volatile("" : "+s"(z)); return z; }
struct Args { const float* in[29]; float* out; unsigned char* ws; };

DI void p0_transpose_item(const float* W, int K, int N, bf16* WT, float* scr, int item, int lane) {
    const int nblk = N / 32, kb = item / nblk, nb = item % nblk, k0 = 64 * kb, n0 = 32 * nb;
    float wv[32];
#pragma unroll
    for (int i = 0; i < 32; ++i) wv[i] = W[(size_t)(k0 + 2 * i + (lane >> 5)) * N + n0 + (lane & 31)];
#pragma unroll
    for (int i = 0; i < 32; ++i) scr[(2 * i + (lane >> 5)) * 33 + (lane & 31)] = wv[i];
    asm volatile("s_waitcnt lgkmcnt(0)" ::: "memory");
    const int c = lane & 7;
#pragma unroll
    for (int j = 0; j < 4; ++j) { const int n = (lane >> 3) + 8 * j; const float* s = scr + (8 * c) * 33 + n;
        v4u o; o.x = pk2(s[0 * 33], s[1 * 33]); o.y = pk2(s[2 * 33], s[3 * 33]); o.z = pk2(s[4 * 33], s[5 * 33]); o.w = pk2(s[6 * 33], s[7 * 33]);
        *(v4u*)(WT + (size_t)(n0 + n) * K + k0 + 8 * c) = o; }
    asm volatile("s_waitcnt lgkmcnt(0)" ::: "memory");
}

DI void p0_prologue(const Args& a, unsigned char* lds, int bid, int G) {
    const int tid = otid(), lane = tid & 63, wave = tid >> 6;
    const int gw = bid * 8 + wave, NGW = G * 8;
    unsigned char* ws = a.ws;
#pragma unroll 1
    for (int ph = 0; ph < 2; ++ph) {
    if (((wave & 1) == 0) == (ph == 0)) {
    {
        float* scr = (float*)(lds + wave * 16384);
        constexpr int I_IN = 16 * 72, I_OUT = 16 * 32, I_1 = 16 * 128, I_2 = 64 * 32, I_L = I_IN + I_OUT + I_1 + I_2;
        for (int it = gw; it < DEPTH * I_L; it += NGW) {
            const int l = it / I_L; int r = it % I_L; unsigned char* wl = ws + WS_W + (size_t)l * W_LAYER;
            if (r < I_IN) { p0_transpose_item(a.in[10] + (size_t)l * 1024 * 2304, 1024, 2304, (bf16*)(wl + WO_IN), scr, r, lane); continue; } r -= I_IN;
            if (r < I_OUT) { p0_transpose_item(a.in[26] + (size_t)l * 1024 * 1024, 1024, 1024, (bf16*)(wl + WO_OUT), scr, r, lane); continue; } r -= I_OUT;
            if (r < I_1) { p0_transpose_item(a.in[27] + (size_t)l * 1024 * 4096, 1024, 4096, (bf16*)(wl + WO_1), scr, r, lane); continue; } r -= I_1;
            p0_transpose_item(a.in[28] + (size_t)l * 4096 * 1024, 4096, 1024, (bf16*)(wl + WO_2), scr, r, lane);
        }
    }
    } else {
    {
        for (int it = gw; it < DEPTH * 2304; it += NGW) {
            const int l = it / 2304, rp = it % 2304; const int LQ = rp < 2048 ? 2048 : 256; const int p = rp < 2048 ? rp : rp - 2048;
            const float* w1 = a.in[15] + (size_t)l * 33 * 64; const float* b1 = a.in[16] + l * 64; const float* w2 = a.in[17] + (size_t)l * 2 * 64 * 64; const float* b2 = a.in[18] + l * 2 * 64;
            const float* w3 = a.in[19] + (size_t)l * 64 * 512; const float fr = a.in[20][l * 64 + lane];
            const float t = (float)p / (float)(LQ - 1); const float w = 6.283185307179586f * (float)p / (float)LQ;
            float zval = 0.f;
            if (lane == 0) zval = t;
            else if (lane <= 32) { const int bi = (lane - 1) & 15; const float band = 1e-4f + (float)bi * ((15.0f - 1e-4f) / 15.0f); const float ang = w * band; zval = lane <= 16 ? cosf(ang) : -sinf(ang); }
            float acc = b1[lane];
#pragma unroll
            for (int e = 0; e < 33; ++e) acc += rdlane(zval, e) * w1[e * 64 + lane];
            float h = sinf(fr * acc);
#pragma unroll 1
            for (int jj = 0; jj < 2; ++jj) { acc = b2[jj * 64 + lane];
#pragma unroll
                for (int i = 0; i < 64; ++i) acc += rdlane(h, i) * w2[(jj * 64 + i) * 64 + lane];
                h = sinf(fr * acc); }
            bf16* R = (LQ == 2048) ? (bf16*)(ws + WS_RF) + ((size_t)l * 256) * 4096 : (bf16*)(ws + WS_RC) + ((size_t)l * 256) * 512;
            const int RS = 2 * LQ;
#pragma unroll 1
            for (int o = 0; o < 8; ++o) { const int col = lane + 64 * o; float s = 0.f;
#pragma unroll
                for (int i = 0; i < 64; ++i) s += rdlane(h, i) * w3[i * 512 + col];
                const int c = col & 255; const float delta = 3.0701134573253945f + (float)c * ((15.350567286626973f - 3.0701134573253945f) / 255.0f);
                const float val = s * expf(-t * delta);
                if (col < 256) R[(size_t)c * RS + (LQ - 1 - p)] = (bf16)f2bf(val);
                else if (p >= 1) R[(size_t)c * RS + (LQ - 1 + p)] = (bf16)f2bf(val); }
            if (p == 0) { for (int c = lane; c < 256; c += 64) R[(size_t)c * RS + RS - 1] = 0; }
        }
    }
    }
    }
    {
        float* rotr = (float*)(ws + WS_ROTR); float* rota = (float*)(ws + WS_ROTA);
        for (int i = bid * 512 + tid; i < 2048 * 16; i += G * 512) { const int pos = i >> 4, f = i & 15;
            const float invr = 1.0f / powf(10000.0f, (float)f / 15.0f); const float ang = (float)pos * invr;
            rotr[pos * 32 + f] = cosf(ang); rotr[pos * 32 + 16 + f] = sinf(ang);
            const float inva = powf(10000.0f, -(float)f / 16.0f); const float ar = (float)(pos >> 6) * inva, ac = (float)(pos & 63) * inva;
            rota[pos * 64 + f] = cosf(ar); rota[pos * 64 + 16 + f] = sinf(ar); rota[pos * 64 + 32 + f] = cosf(ac); rota[pos * 64 + 48 + f] = sinf(ac); }
    }
    __syncthreads();
    {
        float* sil = (float*)lds + wave * (33 * 64);
        float* red = (float*)lds + 8 * 33 * 64;
        float* ada = (float*)(ws + WS_ADA);
        for (int it = bid; it < DEPTH * 96; it += G) {
            const int l = it / 96, n0 = (it % 96) * 64;
            const float* wa = a.in[4] + (size_t)l * 1024 * 6144;
            float acc[33];
#pragma unroll
            for (int b = 0; b < 33; ++b) acc[b] = 0.f;
#pragma unroll 1
            for (int kc = 0; kc < 2; ++kc) { const int k0 = wave * 128 + kc * 64;
#pragma unroll 1
                for (int b = 0; b < 33; ++b) { const float cv = b < 32 ? a.in[1][b * 1024 + k0 + lane] : a.in[3][k0 + lane]; sil[b * 64 + lane] = cv / (1.f + expf(-cv)); }
                asm volatile("s_waitcnt lgkmcnt(0)" ::: "memory");
#pragma unroll 4
                for (int kk = 0; kk < 64; ++kk) { const float wv = wa[(size_t)(k0 + kk) * 6144 + n0 + lane];
#pragma unroll
                    for (int b = 0; b < 33; ++b) acc[b] += sil[b * 64 + kk] * wv; }
                asm volatile("s_waitcnt lgkmcnt(0)" ::: "memory");
            }
#pragma unroll
            for (int b = 0; b < 33; ++b) red[(wave * 33 + b) * 64 + lane] = acc[b];
            __syncthreads();
            for (int o = tid; o < 33 * 64; o += 512) { float s = a.in[5][l * 6144 + n0 + (o & 63)];
#pragma unroll
                for (int w8 = 0; w8 < 8; ++w8) s += red[w8 * 33 * 64 + o];
                ada[((size_t)l * 33 + (o >> 6)) * 6144 + n0 + (o & 63)] = s; }
            __syncthreads();
        }
    }
}

DI void ew_phase(const float* xin_lat, const float* xin_ctx, const bf16* xin_b, float* xout_lat, float* xout_ctx, bf16* xout_b, const bf16* Y, const float* ada_g, int goff, const float* g_post,
                 bf16* H, const float* ada_h, int shoff, int scoff, const float* g_pre, int nrows, int bid, int G) {
    const int tid = otid(); const int lane = tid & 63, wave = tid >> 6;
    const int perb = (nrows + G - 1) / G; const int r0 = bid * perb + wave, r1 = min(nrows, (bid + 1) * perb);
    f32x4 gpo[4], gpr[4], gt[4], sh[4], sc[4];
#pragma unroll
    for (int j = 0; j < 4; ++j) { gpo[j] = Y ? *(const f32x4*)(g_post + 4 * lane + 256 * j) : (f32x4){0.f, 0.f, 0.f, 0.f}; gpr[j] = H ? *(const f32x4*)(g_pre + 4 * lane + 256 * j) : (f32x4){0.f, 0.f, 0.f, 0.f};
        gt[j] = (f32x4){0.f, 0.f, 0.f, 0.f}; sh[j] = gt[j]; sc[j] = gt[j]; }
    int curb = -1;
#pragma unroll 1
    for (int r = r0; r < r1; r += 8) {
        const bool lat = r < TL; const int b = lat ? (r >> 11) : 32;
        f32x4 v[4];
        if (xin_b) {
#pragma unroll
            for (int j = 0; j < 4; ++j) { const v2u w = __builtin_nontemporal_load((const v2u*)(xin_b + (size_t)r * DM + 4 * lane + 256 * j)); v[j] = (f32x4){bflo(w.x), bfhi(w.x), bflo(w.y), bfhi(w.y)}; }
        } else { const float* xr = lat ? xin_lat + (size_t)r * DM : xin_ctx + (size_t)(r - TL) * DM;
#pragma unroll
            for (int j = 0; j < 4; ++j) v[j] = *(const f32x4*)(xr + 4 * lane + 256 * j); }
        v2u yw[4];
        if (Y) {
#pragma unroll
            for (int j = 0; j < 4; ++j) yw[j] = __builtin_nontemporal_load((const v2u*)(Y + (size_t)r * DM + 4 * lane + 256 * j));
        }
        if (b != curb) { curb = b;
#pragma unroll
            for (int j = 0; j < 4; ++j) { if (Y) gt[j] = *(const f32x4*)(ada_g + (size_t)b * 6144 + goff + 4 * lane + 256 * j);
                if (H) { sh[j] = *(const f32x4*)(ada_h + (size_t)b * 6144 + shoff + 4 * lane + 256 * j); sc[j] = *(const f32x4*)(ada_h + (size_t)b * 6144 + scoff + 4 * lane + 256 * j) + 1.0f; } } }
        if (Y) {
            f32x4 y[4]; float ss = 0.f;
#pragma unroll
            for (int j = 0; j < 4; ++j) { y[j] = (f32x4){bflo(yw[j].x), bfhi(yw[j].x), bflo(yw[j].y), bfhi(yw[j].y)};
                ss += y[j].x * y[j].x + y[j].y * y[j].y + y[j].z * y[j].z + y[j].w * y[j].w; }
            const float rinv = 1.0f / sqrtf(wave_sum(ss) * (1.0f / DM) + EPSN);
#pragma unroll
            for (int j = 0; j < 4; ++j) v[j] = v[j] + gt[j] * (y[j] * rinv * gpo[j]);
            if (xout_b) {
#pragma unroll
                for (int j = 0; j < 4; ++j) { v2u w; w.x = pk2(v[j].x, v[j].y); w.y = pk2(v[j].z, v[j].w); __builtin_nontemporal_store(w, (v2u*)(xout_b + (size_t)r * DM + 4 * lane + 256 * j)); }
            } else { float* xo = lat ? xout_lat + (size_t)r * DM : xout_ctx + (size_t)(r - TL) * DM;
#pragma unroll
                for (int j = 0; j < 4; ++j) *(f32x4*)(xo + 4 * lane + 256 * j) = v[j]; }
        }
        if (H) {
            float ss = 0.f;
#pragma unroll
            for (int j = 0; j < 4; ++j) ss += v[j].x * v[j].x + v[j].y * v[j].y + v[j].z * v[j].z + v[j].w * v[j].w;
            const float rinv = 1.0f / sqrtf(wave_sum(ss) * (1.0f / DM) + EPSN);
#pragma unroll
            for (int j = 0; j < 4; ++j) { const f32x4 hv = (v[j] * rinv * gpr[j]) * sc[j] + sh[j];
                v2u w; w.x = pk2(hv.x, hv.y); w.y = pk2(hv.z, hv.w); *(v2u*)(H + (size_t)r * DM + 4 * lane + 256 * j) = w; }
        }
    }
}

DI void attn_item(const bf16* P, bf16* MIXO, const float* sinkp, const float* g_att, unsigned char* lds, int qrow0, int qpos0, int brow_lat, int brow_ctx, bool is_ctx) {
    const int tid = otid(), lane = tid & 63, w = tid >> 6, g = w >> 2, r = lane & 31, h = lane >> 5;
    constexpr int KVB = 2 * 2 * 64 * 72;
    bf16* KV0 = (bf16*)lds;
    float* ssq = (float*)(lds + 2 * KVB * 2);
    bf16* Ql = (bf16*)(lds + 2 * KVB * 2 + 2048) + w * (64 * 72);
    const int bi0 = is_ctx ? 0 : (qpos0 >= 128 ? 0 : (qpos0 >= 64 ? 1 : 2));
    const int bi1 = is_ctx ? -1 : min(4, (SEQ + 127 - qpos0) >> 6);
    const int nband = is_ctx ? 0 : bi1 - bi0 + 1, ntiles = nband + 4;
    const int spair = tid & 31, sg = tid >> 8, spart = (tid >> 5) & 7;
    v4u pk[2], pv[2];
#define ATT_TILE_ROW(t) ((t) < nband ? brow_lat + qpos0 - 128 + 64 * (bi0 + (t)) : brow_ctx + 64 * ((t) - nband))
#define ATT_LOAD(t) do { const bf16* src_ = P + (size_t)(ATT_TILE_ROW(t) + 2 * spair) * DIN + 64 * sg + 8 * spart; \
        pk[0] = *(const v4u*)(src_ + C_AK); pk[1] = *(const v4u*)(src_ + DIN + C_AK); pv[0] = *(const v4u*)(src_ + C_AV); pv[1] = *(const v4u*)(src_ + DIN + C_AV); } while (0)
#define ATT_STORE(buf) do { bf16* Kd_ = KV0 + (buf) * KVB; bf16* Vd_ = Kd_ + 2 * 64 * 72; \
        *(v4u*)(Kd_ + (sg * 64 + 2 * spair) * 72 + 8 * spart) = pk[0]; *(v4u*)(Kd_ + (sg * 64 + 2 * spair + 1) * 72 + 8 * spart) = pk[1]; \
        unsigned* vd = (unsigned*)(Vd_ + (sg * 64 + 8 * spart) * 72 + 2 * spair); const v4u a_ = pv[0], b_ = pv[1]; \
        vd[0 * 36] = (a_.x & 0xffffu) | (b_.x << 16); vd[1 * 36] = (a_.x >> 16) | (b_.x & 0xffff0000u); \
        vd[2 * 36] = (a_.y & 0xffffu) | (b_.y << 16); vd[3 * 36] = (a_.y >> 16) | (b_.y & 0xffff0000u); \
        vd[4 * 36] = (a_.z & 0xffffu) | (b_.z << 16); vd[5 * 36] = (a_.z >> 16) | (b_.z & 0xffff0000u); \
        vd[6 * 36] = (a_.w & 0xffffu) | (b_.w << 16); vd[7 * 36] = (a_.w >> 16) | (b_.w & 0xffff0000u); } while (0)
    ATT_LOAD(0);
#pragma unroll
    for (int i = 0; i < 8; ++i) { const int c = lane + 64 * i, row = c >> 3, part = c & 7;
        *(v4u*)(Ql + row * 72 + 8 * part) = *(const v4u*)(P + (size_t)(qrow0 + row) * DIN + C_AQ + 64 * w + 8 * part); }
    f32x16 O[2][2];
#pragma unroll
    for (int qb = 0; qb < 2; ++qb)
#pragma unroll
        for (int db = 0; db < 2; ++db)
#pragma unroll
            for (int i = 0; i < 16; ++i) O[qb][db][i] = 0.f;
    const float sk = sinkp[w] * LOG2E;
    float mrun[2] = {sk, sk}, lrun[2] = {h == 0 ? 1.f : 0.f, h == 0 ? 1.f : 0.f};
    __syncthreads();
    ATT_STORE(0);
#pragma unroll 1
    for (int t = 0; t < ntiles; ++t) {
        const bool band = t < nband; const int bi = bi0 + t;
        const int kpos0 = qpos0 - 128 + 64 * bi; const bool need_mask = band && (bi == 0 || bi == 4);
        if (t + 1 < ntiles) ATT_LOAD(t + 1);
        __syncthreads();
        const bf16* Kl = KV0 + (t & 1) * KVB; const bf16* Vl = Kl + 2 * 64 * 72;
        bf16x8 Kf[2][4], Pf[2][2][2];
#pragma unroll
        for (int kb = 0; kb < 2; ++kb)
#pragma unroll
            for (int s = 0; s < 4; ++s) Kf[kb][s] = *(const bf16x8*)(Kl + (g * 64 + 32 * kb + r) * 72 + 16 * s + 8 * h);
#pragma unroll
        for (int qb = 0; qb < 2; ++qb) {
            f32x16 S[2];
#pragma unroll
            for (int kb = 0; kb < 2; ++kb)
#pragma unroll
                for (int i = 0; i < 16; ++i) S[kb][i] = 0.f;
#pragma unroll
            for (int s = 0; s < 4; ++s) { const bf16x8 qf = *(const bf16x8*)(Ql + (32 * qb + r) * 72 + 16 * s + 8 * h);
                S[0] = MFMA32(Kf[0][s], qf, S[0]); S[1] = MFMA32(Kf[1][s], qf, S[1]); }
            if (need_mask) { const int qp = qpos0 + 32 * qb + r;
#pragma unroll
                for (int kb = 0; kb < 2; ++kb)
#pragma unroll
                    for (int i = 0; i < 16; ++i) { const int kp = kpos0 + 32 * kb + (i & 3) + 8 * (i >> 2) + 4 * h; const int d = kp - qp; if (d > 128 || d < -128) S[kb][i] = -1e30f; } }
            float mx = fmaxf(S[0][0], S[1][0]);
#pragma unroll
            for (int i = 1; i < 16; ++i) mx = fmaxf(mx, fmaxf(S[0][i], S[1][i]));
            mx = fmaxf(mx, __shfl_xor(mx, 32));
            const float mnew = fmaxf(mrun[qb], mx);
            float ps = 0.f;
#pragma unroll
            for (int kb = 0; kb < 2; ++kb)
#pragma unroll
                for (int i = 0; i < 16; ++i) { S[kb][i] = __builtin_amdgcn_exp2f(S[kb][i] - mnew); ps += S[kb][i]; }
            if (__builtin_amdgcn_ballot_w64(mnew > mrun[qb]) != 0ull) {
                const float alpha = __builtin_amdgcn_exp2f(mrun[qb] - mnew);
                lrun[qb] *= alpha;
#pragma unroll
                for (int db = 0; db < 2; ++db)
#pragma unroll
                    for (int i = 0; i < 16; ++i) O[qb][db][i] *= alpha;
            }
            lrun[qb] += ps; mrun[qb] = mnew;
#pragma unroll
            for (int kb = 0; kb < 2; ++kb)
#pragma unroll
                for (int u = 0; u < 2; ++u) { v4u pw; pw.x = pk2(S[kb][8 * u + 0], S[kb][8 * u + 1]); pw.y = pk2(S[kb][8 * u + 2], S[kb][8 * u + 3]); pw.z = pk2(S[kb][8 * u + 4], S[kb][8 * u + 5]); pw.w = pk2(S[kb][8 * u + 6], S[kb][8 * u + 7]);
                    Pf[qb][kb][u] = __builtin_bit_cast(bf16x8, pw); }
        }
#pragma unroll
        for (int kb = 0; kb < 2; ++kb) {
            bf16x8 Vf[2][2];
#pragma unroll
            for (int db = 0; db < 2; ++db)
#pragma unroll
                for (int u = 0; u < 2; ++u) { const bf16* vp = Vl + (g * 64 + 32 * db + r) * 72 + 32 * kb + 16 * u + 4 * h;
                    const s16x4 lo = *(const s16x4*)vp, hi = *(const s16x4*)(vp + 8);
                    Vf[db][u] = __builtin_shufflevector(lo, hi, 0, 1, 2, 3, 4, 5, 6, 7); }
#pragma unroll
            for (int qb = 0; qb < 2; ++qb)
#pragma unroll
                for (int db = 0; db < 2; ++db)
#pragma unroll
                    for (int u = 0; u < 2; ++u) O[qb][db] = MFMA32(Vf[db][u], Pf[qb][kb][u], O[qb][db]);
        }
        if (t + 1 < ntiles) ATT_STORE((t + 1) & 1);
    }
#undef ATT_TILE_ROW
#undef ATT_LOAD
#undef ATT_STORE
#pragma unroll
    for (int qb = 0; qb < 2; ++qb) {
        const float lt = lrun[qb] + __shfl_xor(lrun[qb], 32); const float inv = 1.0f / lt; float ss = 0.f;
#pragma unroll
        for (int db = 0; db < 2; ++db)
#pragma unroll
            for (int i = 0; i < 16; ++i) { O[qb][db][i] *= inv; ss += O[qb][db][i] * O[qb][db][i]; }
        ss += __shfl_xor(ss, 32);
        if (h == 0) ssq[w * 64 + 32 * qb + r] = ss;
    }
    __syncthreads();
#pragma unroll
    for (int qb = 0; qb < 2; ++qb) {
        float tot = 0.f;
#pragma unroll
        for (int w8 = 0; w8 < 8; ++w8) tot += ssq[w8 * 64 + 32 * qb + r];
        const float rinv = 1.0f / sqrtf(tot * (1.0f / 512.0f) + EPSN);
        bf16* orow = MIXO + (size_t)(qrow0 + 32 * qb + r) * DM + 512 + 64 * w;
#pragma unroll
        for (int db = 0; db < 2; ++db)
#pragma unroll
            for (int i4 = 0; i4 < 4; ++i4) { const int d = 32 * db + 8 * i4 + 4 * h; const f32x4 gg = *(const f32x4*)(g_att + 64 * w + d);
                v2u o; o.x = pk2(O[qb][db][4 * i4 + 0] * rinv * gg.x, O[qb][db][4 * i4 + 1] * rinv * gg.y); o.y = pk2(O[qb][db][4 * i4 + 2] * rinv * gg.z, O[qb][db][4 * i4 + 3] * rinv * gg.w);
                *(v2u*)(orow + d) = o; }
    }
    __syncthreads();
}

DI float ldhy(const bf16* P, int rowbase, int t, int LQ, int col) { return (t >= 0 && t < LQ) ? bf2f(P[(size_t)(rowbase + t) * DIN + C_HY + col]) : 0.f; }

DI v4u ldrow8(const bf16* P, int rowbase, int t, int LQ, int col) { v4u z = {0u, 0u, 0u, 0u}; return (t >= 0 && t < LQ) ? *(const v4u*)(P + (size_t)(rowbase + t) * DIN + C_HY + col) : z; }
DI float bfsel(const v4u& q, int k) { const unsigned w = (k >> 1) == 0 ? q.x : ((k >> 1) == 1 ? q.y : ((k >> 1) == 2 ? q.z : q.w)); return (k & 1) ? bfhi(w) : bflo(w); }
DI void hypre_item(const bf16* P, const float* sw, const float* sbias, bf16* Zt, unsigned char* lds, int rowbase, int b, int t0, int LQ) {
    const int tid = otid(); bf16* zl = (bf16*)lds;
    { const size_t oz = ozero(); sw += oz; sbias += oz; }
    const int lane = tid & 63, ts = lane & 15, cg = (tid >> 6) * 4 + (lane >> 4), c0 = 8 * cg, tb = t0 + 4 * ts;
    __syncthreads();
    v4u rv[6], rx[6];
#pragma unroll
    for (int i = 0; i < 6; ++i) { rv[i] = ldrow8(P, rowbase, tb - 1 + i, LQ, c0); rx[i] = ldrow8(P, rowbase, tb - 1 + i, LQ, 256 + c0); }
#pragma unroll
    for (int k = 0; k < 8; ++k) {
        const float w0v = sw[c0 + k], w1v = sw[768 + c0 + k], w2v = sw[1536 + c0 + k], bv = sbias[c0 + k];
        const float w0x = sw[256 + c0 + k], w1x = sw[768 + 256 + c0 + k], w2x = sw[1536 + 256 + c0 + k], bx = sbias[256 + c0 + k];
        float z[4];
#pragma unroll
        for (int tt = 0; tt < 4; ++tt) { const float uv = w0v * bfsel(rv[tt], k) + w1v * bfsel(rv[tt + 1], k) + w2v * bfsel(rv[tt + 2], k) + bv;
            const float ux = w0x * bfsel(rx[tt], k) + w1x * bfsel(rx[tt + 1], k) + w2x * bfsel(rx[tt + 2], k) + bx; z[tt] = uv * ux; }
        v2u o; o.x = pk2(z[0], z[1]); o.y = pk2(z[2], z[3]);
        *(v2u*)(zl + (c0 + k) * 72 + 4 * ts) = o; }
    __syncthreads();
    { const int c2 = tid >> 1, hh = tid & 1;
#pragma unroll
      for (int i = 0; i < 4; ++i) *(v4u*)(Zt + ((size_t)c2 * 32 + b) * LQ + t0 + 32 * hh + 8 * i) = *(const v4u*)(zl + c2 * 72 + 32 * hh + 8 * i); }
}

template <int LQ> DI void hyconv_item(const bf16* Ztc, const bf16* R, bf16* Ytc, unsigned char* lds) {
    constexpr int ZS = LQ + 8;
    const int tid = otid(), lane = tid & 63, wave = tid >> 6, r = lane & 31, h = lane >> 5;
    bf16* Zl = (bf16*)lds; bf16* R0 = Zl + 32 * ZS; bf16* R1 = R0 + 2 * LQ;
    __syncthreads();
    for (int c = tid; c < 32 * LQ / 8; c += 512) { const int b = c / (LQ / 8), part = c % (LQ / 8); *(v4u*)(Zl + b * ZS + 8 * part) = *(const v4u*)(Ztc + (size_t)b * LQ + 8 * part); }
    for (int x = tid; x < 2 * LQ; x += 512) { R0[x] = R[x]; R1[x] = (x + 1 < 2 * LQ) ? R[x + 1] : (bf16)0; }
    __syncthreads();
    constexpr int TPW = LQ / 8 / 32;
    const int tw = wave * (LQ / 8);
    f32x16 acc[TPW];
#pragma unroll
    for (int k = 0; k < TPW; ++k)
#pragma unroll
        for (int i = 0; i < 16; ++i) acc[k][i] = 0.f;
    const bf16* abase = (r & 1) ? (R0 + (LQ - 1) - r + 8 * h) : (R1 + (LQ - 2) - r + 8 * h);
    const bf16* bbase = Zl + r * ZS + 8 * h;
    const int dmid0 = tw + 32 * (TPW - 1) - (LQ - 16), dmid1 = tw;
#pragma unroll 1
    for (int d = tw - (LQ - 16); d <= tw + 32 * (TPW - 1); d += 16) {
        if (d == dmid0) {
#pragma unroll 1
            for (; d <= dmid1; d += 16) {
                const unsigned* ap = (const unsigned*)(abase - d);
                v4u av; av.x = ap[0]; av.y = ap[1]; av.z = ap[2]; av.w = ap[3];
                const bf16x8 A = __builtin_bit_cast(bf16x8, av);
                bf16x8 Bv[TPW];
#pragma unroll
                for (int k = 0; k < TPW; ++k) Bv[k] = *(const bf16x8*)(bbase + (tw + 32 * k - d));
#pragma unroll
                for (int k = 0; k < TPW; ++k) acc[k] = MFMA32(A, Bv[k], acc[k]);
            }
            if (d > tw + 32 * (TPW - 1)) break;
        }
        const unsigned* ap = (const unsigned*)(abase - d);
        v4u av; av.x = ap[0]; av.y = ap[1]; av.z = ap[2]; av.w = ap[3];
        const bf16x8 A = __builtin_bit_cast(bf16x8, av);
#pragma unroll
        for (int k = 0; k < TPW; ++k) { const int s0 = tw + 32 * k - d;
            if (s0 >= 0 && s0 < LQ) { const bf16x8 B = *(const bf16x8*)(bbase + s0); acc[k] = MFMA32(A, B, acc[k]); } }
    }
#pragma unroll
    for (int k = 0; k < TPW; ++k)
#pragma unroll
        for (int i4 = 0; i4 < 4; ++i4) { const int t = tw + 32 * k + 8 * i4 + 4 * h;
            v2u o; o.x = pk2(acc[k][4 * i4 + 0], acc[k][4 * i4 + 1]); o.y = pk2(acc[k][4 * i4 + 2], acc[k][4 * i4 + 3]);
            *(v2u*)(Ytc + (size_t)r * LQ + t) = o; }
}

DI void hypost_item(const bf16* P, const float* sw, const float* sbias, const float* hbias, const float* g_hy, const bf16* Yt, bf16* MIXO, unsigned char* lds, int rowbase, int b, int t0, int LQ) {
    const int tid = otid(), lane = tid & 63, wave = tid >> 6;
    bf16* yl = (bf16*)lds; float* ol = (float*)(lds + 256 * 72 * 2);
    { const size_t oz = ozero(); sw += oz; sbias += oz; hbias += oz; g_hy += oz; }
    const int ts = lane & 15, cg = wave * 4 + (lane >> 4), c0 = 8 * cg, tb = t0 + 4 * ts;
    __syncthreads();
    { const int c2 = tid >> 1, hh = tid & 1;
#pragma unroll
      for (int i = 0; i < 4; ++i) *(v4u*)(yl + c2 * 72 + 32 * hh + 8 * i) = *(const v4u*)(Yt + ((size_t)c2 * 32 + b) * LQ + t0 + 32 * hh + 8 * i); }
    v4u rv[6], rx[6], ro[6];
#pragma unroll
    for (int i = 0; i < 6; ++i) { rv[i] = ldrow8(P, rowbase, tb - 1 + i, LQ, c0); rx[i] = ldrow8(P, rowbase, tb - 1 + i, LQ, 256 + c0); ro[i] = ldrow8(P, rowbase, tb - 1 + i, LQ, 512 + c0); }
    __syncthreads();
    float res[4][8];
#pragma unroll
    for (int k = 0; k < 8; ++k) {
        const float w0v = sw[c0 + k], w1v = sw[768 + c0 + k], w2v = sw[1536 + c0 + k], bv = sbias[c0 + k];
        const float w0x = sw[256 + c0 + k], w1x = sw[768 + 256 + c0 + k], w2x = sw[1536 + 256 + c0 + k], bx = sbias[256 + c0 + k];
        const float w0o = sw[512 + c0 + k], w1o = sw[768 + 512 + c0 + k], w2o = sw[1536 + 512 + c0 + k], bo = sbias[512 + c0 + k];
        const float hb = hbias[c0 + k];
        const v2u yq = *(const v2u*)(yl + (c0 + k) * 72 + 4 * ts);
        const float yv[4] = {bflo(yq.x), bfhi(yq.x), bflo(yq.y), bfhi(yq.y)};
#pragma unroll
        for (int tt = 0; tt < 4; ++tt) { const float uv = w0v * bfsel(rv[tt], k) + w1v * bfsel(rv[tt + 1], k) + w2v * bfsel(rv[tt + 2], k) + bv;
            const float ux = w0x * bfsel(rx[tt], k) + w1x * bfsel(rx[tt + 1], k) + w2x * bfsel(rx[tt + 2], k) + bx;
            const float uo = w0o * bfsel(ro[tt], k) + w1o * bfsel(ro[tt + 1], k) + w2o * bfsel(ro[tt + 2], k) + bo;
            res[tt][k] = (yv[tt] + uv * ux * hb) * uo; } }
#pragma unroll
    for (int tt = 0; tt < 4; ++tt) { float* od = ol + (4 * ts + tt) * 260 + c0;
        *(f32x4*)od = (f32x4){res[tt][0], res[tt][1], res[tt][2], res[tt][3]}; *(f32x4*)(od + 4) = (f32x4){res[tt][4], res[tt][5], res[tt][6], res[tt][7]}; }
    __syncthreads();
    { const int tt = 8 * wave + (lane >> 3), sub = lane & 7;
      f32x4 v[8]; float ss = 0.f;
#pragma unroll
      for (int q = 0; q < 8; ++q) { v[q] = *(const f32x4*)(ol + tt * 260 + 4 * sub + 32 * q); ss += v[q].x * v[q].x + v[q].y * v[q].y + v[q].z * v[q].z + v[q].w * v[q].w; }
      ss += dpp_mov<0xB1>(ss); ss += dpp_mov<0x4E>(ss); ss += dpp_mov<0x141>(ss);
      const float rinv = 1.0f / sqrtf(ss * (1.0f / 256.0f) + EPSN);
      bf16* orow = MIXO + (size_t)(rowbase + t0 + tt) * DM + 256 + 4 * sub;
#pragma unroll
      for (int q = 0; q < 8; ++q) { const f32x4 gg = *(const f32x4*)(g_hy + 4 * sub + 32 * q);
          v2u o; o.x = pk2(v[q].x * rinv * gg.x, v[q].y * rinv * gg.y); o.y = pk2(v[q].z * rinv * gg.z, v[q].w * rinv * gg.w);
          *(v2u*)(orow + 32 * q) = o; } }
}

DI int ret_rowbase(int b, int np) { return np < 2 ? TL + b * LC + 128 * np : b * SEQ + 128 * (np - 2); }
DI float ret_l2g(const float* dec, int h) { return log1pf(-expf(dec[h])) * LOG2E; }

DI void ret_stage_vt(const bf16* P, int rowbase, bf16* VT, int tid) {
#pragma unroll 2
    for (int i = 0; i < 8; ++i) { const int c = tid + 512 * i, part = c >> 7, j = c & 127;
        const v4u q = *(const v4u*)(P + (size_t)(rowbase + j) * DIN + C_RV + 8 * part);
        bf16* vd = VT + (8 * part) * 136 + j;
        vd[0 * 136] = (bf16)(q.x & 0xffffu); vd[1 * 136] = (bf16)(q.x >> 16); vd[2 * 136] = (bf16)(q.y & 0xffffu); vd[3 * 136] = (bf16)(q.y >> 16);
        vd[4 * 136] = (bf16)(q.z & 0xffffu); vd[5 * 136] = (bf16)(q.z >> 16); vd[6 * 136] = (bf16)(q.w & 0xffffu); vd[7 * 136] = (bf16)(q.w >> 16); }
}

DI void retkv_mfma_item(const bf16* P, float* KV, const float* dec_f, const float* dec_b, unsigned char* lds, int b, int np) {
    const int tid = otid(), lane = tid & 63, w = tid >> 6, r = lane & 31, hh = lane >> 5;
    bf16* VT = (bf16*)lds; bf16* KFT = VT + 4 * 64 * 136; bf16* KBT = KFT + 4 * 32 * 136;
    const int rowbase = ret_rowbase(b, np);
    __syncthreads();
    ret_stage_vt(P, rowbase, VT, tid);
#pragma unroll 2
    for (int i = 0; i < 4; ++i) { const int c = tid + 512 * i, part = c >> 7, j = c & 127, h = part >> 2;
        const float l2f = ret_l2g(dec_f, h), l2b = ret_l2g(dec_b, h);
        const float wf = exp2f(l2f * (float)(127 - j)), wb = exp2f(l2b * (float)j);
        const v4u q = *(const v4u*)(P + (size_t)(rowbase + j) * DIN + C_RK + 8 * part);
        const float k0 = bflo(q.x), k1 = bfhi(q.x), k2 = bflo(q.y), k3 = bfhi(q.y), k4 = bflo(q.z), k5 = bfhi(q.z), k6 = bflo(q.w), k7 = bfhi(q.w);
        bf16* fd = KFT + (8 * part) * 136 + j; bf16* bd = KBT + (8 * part) * 136 + j;
        fd[0 * 136] = (bf16)f2bf(k0 * wf); fd[1 * 136] = (bf16)f2bf(k1 * wf); fd[2 * 136] = (bf16)f2bf(k2 * wf); fd[3 * 136] = (bf16)f2bf(k3 * wf);
        fd[4 * 136] = (bf16)f2bf(k4 * wf); fd[5 * 136] = (bf16)f2bf(k5 * wf); fd[6 * 136] = (bf16)f2bf(k6 * wf); fd[7 * 136] = (bf16)f2bf(k7 * wf);
        bd[0 * 136] = (bf16)f2bf(k0 * wb); bd[1 * 136] = (bf16)f2bf(k1 * wb); bd[2 * 136] = (bf16)f2bf(k2 * wb); bd[3 * 136] = (bf16)f2bf(k3 * wb);
        bd[4 * 136] = (bf16)f2bf(k4 * wb); bd[5 * 136] = (bf16)f2bf(k5 * wb); bd[6 * 136] = (bf16)f2bf(k6 * wb); bd[7 * 136] = (bf16)f2bf(k7 * wb); }
    __syncthreads();
    const int h = w & 3, dir = w >> 2;
    const bf16* KT = (dir ? KBT : KFT) + (h * 32 + r) * 136 + 8 * hh;
    const bf16* VB = VT + (h * 64 + r) * 136 + 8 * hh;
    f32x16 C[2];
#pragma unroll
    for (int eb = 0; eb < 2; ++eb)
#pragma unroll
        for (int i = 0; i < 16; ++i) C[eb][i] = 0.f;
#pragma unroll
    for (int ks = 0; ks < 8; ++ks) { const bf16x8 A = *(const bf16x8*)(KT + 16 * ks);
#pragma unroll
        for (int eb = 0; eb < 2; ++eb) { const bf16x8 B = *(const bf16x8*)(VB + (32 * eb) * 136 + 16 * ks); C[eb] = MFMA32(A, B, C[eb]); } }
    float* o = KV + (size_t)dir * NB * NCH * 4 * 2048 + ((size_t)(b * NCH + np) * 4 + h) * 2048 + r;
#pragma unroll
    for (int eb = 0; eb < 2; ++eb)
#pragma unroll
        for (int i = 0; i < 16; ++i) o[((i & 3) + 8 * (i >> 2) + 4 * hh) * 64 + 32 * eb] = C[eb][i];
}

DI void ret_scan_task(float* KV, const float* dec_f, const float* dec_b, int t, int lane) {
    const int b = t >> 6, rem = t & 63, h = rem >> 4, dir = (rem >> 3) & 1, dq = rem & 7;
    const float cdec = exp2f(ret_l2g(dir ? dec_b : dec_f, h) * 128.f);
    const size_t base = (size_t)dir * NB * NCH * 4 * 2048 + ((size_t)(b * NCH) * 4 + h) * 2048 + (size_t)(4 * dq) * 64 + lane;
    const float* src = KV + base; float* dst = KV + (size_t)2 * NB * NCH * 4 * 2048 + base;
    float v[18][4];
#pragma unroll
    for (int k = 0; k < 18; ++k) { const int m = dir ? (k == 0 ? 1 : (k == 1 ? 0 : 19 - k)) : k;
#pragma unroll
        for (int dd = 0; dd < 4; ++dd) v[k][dd] = src[(size_t)m * 4 * 2048 + dd * 64]; }
    float sst[4] = {0.f, 0.f, 0.f, 0.f};
#pragma unroll
    for (int k = 0; k < 18; ++k) { const int m = dir ? (k == 0 ? 1 : (k == 1 ? 0 : 19 - k)) : k;
#pragma unroll
        for (int dd = 0; dd < 4; ++dd) { dst[(size_t)m * 4 * 2048 + dd * 64] = sst[dd]; sst[dd] = cdec * sst[dd] + v[k][dd]; } }
}

DI void retout_mfma_item(const bf16* P, const float* KV, bf16* MIXO, const float* dec_f, const float* dec_b, const float* g_ret, unsigned char* lds, int b, int np) {
    const int tid = otid(), lane = tid & 63, w = tid >> 6, r = lane & 31, hh = lane >> 5;
    bf16* VT = (bf16*)lds; bf16* STT = VT + 4 * 64 * 136; float* ssq = (float*)(STT + 8 * 64 * 40);
    const int rowbase = ret_rowbase(b, np);
    __syncthreads();
    ret_stage_vt(P, rowbase, VT, tid);
    {
        const int h = w & 3, dir = w >> 2;
        float sreg[32];
        const float* src = KV + (size_t)(2 + dir) * NB * NCH * 4 * 2048 + ((size_t)(b * NCH + np) * 4 + h) * 2048 + lane;
#pragma unroll
        for (int d = 0; d < 32; ++d) sreg[d] = src[d * 64];
        bf16* sd = STT + (w * 64 + lane) * 40;
#pragma unroll
        for (int d4 = 0; d4 < 4; ++d4) { v4u o; o.x = pk2(sreg[8 * d4], sreg[8 * d4 + 1]); o.y = pk2(sreg[8 * d4 + 2], sreg[8 * d4 + 3]); o.z = pk2(sreg[8 * d4 + 4], sreg[8 * d4 + 5]); o.w = pk2(sreg[8 * d4 + 6], sreg[8 * d4 + 7]);
            *(v4u*)(sd + 8 * d4) = o; }
    }
    __syncthreads();
    const int h = w & 3, qh = w >> 2;
    const float l2f = ret_l2g(dec_f, h), l2b = ret_l2g(dec_b, h);
    bf16x8 Qf[2][2];
#pragma unroll
    for (int qb = 0; qb < 2; ++qb)
#pragma unroll
        for (int s = 0; s < 2; ++s) Qf[qb][s] = *(const bf16x8*)(P + (size_t)(rowbase + 64 * qh + 32 * qb + r) * DIN + C_RQ + 32 * h + 16 * s + 8 * hh);
    float cf1[4], cf8[4], cb1[4], cb8[4];
#pragma unroll
    for (int i = 0; i < 4; ++i) { cf1[i] = exp2f(-l2f * (float)i); cf8[i] = exp2f(-l2f * (float)(8 * i + 4 * hh)); cb1[i] = exp2f(l2b * (float)i); cb8[i] = exp2f(l2b * (float)(8 * i + 4 * hh)); }
    f32x16 O[2][2];
#pragma unroll
    for (int qb = 0; qb < 2; ++qb)
#pragma unroll
        for (int eb = 0; eb < 2; ++eb)
#pragma unroll
            for (int i = 0; i < 16; ++i) O[qb][eb][i] = 0.f;
#pragma unroll 1
    for (int jb = 0; jb < 4; ++jb) {
        bf16x8 Kf[2];
#pragma unroll
        for (int s = 0; s < 2; ++s) Kf[s] = *(const bf16x8*)(P + (size_t)(rowbase + 32 * jb + r) * DIN + C_RK + 32 * h + 16 * s + 8 * hh);
        bf16x8 Vf[2][2];
#pragma unroll
        for (int eb = 0; eb < 2; ++eb)
#pragma unroll
            for (int u = 0; u < 2; ++u) { const bf16* vp = VT + (h * 64 + 32 * eb + r) * 136 + 32 * jb + 16 * u + 4 * hh;
                const s16x4 lo = *(const s16x4*)vp, hi = *(const s16x4*)(vp + 8); Vf[eb][u] = __builtin_shufflevector(lo, hi, 0, 1, 2, 3, 4, 5, 6, 7); }
#pragma unroll
        for (int qb = 0; qb < 2; ++qb) {
            f32x16 S;
#pragma unroll
            for (int i = 0; i < 16; ++i) S[i] = 0.f;
#pragma unroll
            for (int s = 0; s < 2; ++s) S = MFMA32(Kf[s], Qf[qb][s], S);
            const int qbg = 2 * qh + qb; const float iloc = (float)(32 * qbg + r);
            if (jb < qbg) { const float rf = exp2f(l2f * (iloc - (float)(32 * jb)));
#pragma unroll
                for (int i4 = 0; i4 < 4; ++i4) { const float r8 = rf * cf8[i4];
#pragma unroll
                    for (int i = 0; i < 4; ++i) S[4 * i4 + i] *= r8 * cf1[i]; } }
            else if (jb > qbg) { const float rb = exp2f(l2b * ((float)(32 * jb) - iloc));
#pragma unroll
                for (int i4 = 0; i4 < 4; ++i4) { const float r8 = rb * cb8[i4];
#pragma unroll
                    for (int i = 0; i < 4; ++i) S[4 * i4 + i] *= r8 * cb1[i]; } }
            else {
#pragma unroll
                for (int i = 0; i < 16; ++i) { const int diff = r - ((i & 3) + 8 * (i >> 2) + 4 * hh); float wgt = 0.f;
                    if (diff >= 0) wgt += exp2f(l2f * (float)diff);
                    if (diff <= 0) wgt += exp2f(-l2b * (float)diff);
                    S[i] *= wgt; } }
            bf16x8 Pf[2];
#pragma unroll
            for (int u = 0; u < 2; ++u) { v4u pw; pw.x = pk2(S[8 * u + 0], S[8 * u + 1]); pw.y = pk2(S[8 * u + 2], S[8 * u + 3]); pw.z = pk2(S[8 * u + 4], S[8 * u + 5]); pw.w = pk2(S[8 * u + 6], S[8 * u + 7]);
                Pf[u] = __builtin_bit_cast(bf16x8, pw); }
#pragma unroll
            for (int eb = 0; eb < 2; ++eb)
#pragma unroll
                for (int u = 0; u < 2; ++u) O[qb][eb] = MFMA32(Vf[eb][u], Pf[u], O[qb][eb]);
        }
    }
#pragma unroll
    for (int dir = 0; dir < 2; ++dir)
#pragma unroll
        for (int eb = 0; eb < 2; ++eb) {
            bf16x8 Sf[2];
#pragma unroll
            for (int s = 0; s < 2; ++s) Sf[s] = *(const bf16x8*)(STT + ((dir * 4 + h) * 64 + 32 * eb + r) * 40 + 16 * s + 8 * hh);
#pragma unroll
            for (int qb = 0; qb < 2; ++qb) { f32x16 X;
#pragma unroll
                for (int i = 0; i < 16; ++i) X[i] = 0.f;
#pragma unroll
                for (int s = 0; s < 2; ++s) X = MFMA32(Sf[s], Qf[qb][s], X);
                const float iloc = (float)(64 * qh + 32 * qb + r);
                const float fac = dir ? exp2f(l2b * (128.f - iloc)) : exp2f(l2f * (iloc + 1.f));
#pragma unroll
                for (int i = 0; i < 16; ++i) O[qb][eb][i] += fac * X[i]; }
        }
#pragma unroll
    for (int qb = 0; qb < 2; ++qb) {
        float ss = 0.f;
#pragma unroll
        for (int eb = 0; eb < 2; ++eb)
#pragma unroll
            for (int i = 0; i < 16; ++i) ss += O[qb][eb][i] * O[qb][eb][i];
        ss += __shfl_xor(ss, 32);
        const float rinv = 1.0f / sqrtf(ss * (1.0f / 64.0f) + EPSN);
        const bf16* grow = P + (size_t)(rowbase + 64 * qh + 32 * qb + r) * DIN + C_RG + 64 * h;
        float s2 = 0.f;
#pragma unroll
        for (int eb = 0; eb < 2; ++eb)
#pragma unroll
            for (int i4 = 0; i4 < 4; ++i4) { const v2u gq = *(const v2u*)(grow + 32 * eb + 8 * i4 + 4 * hh);
                const float g0 = bflo(gq.x), g1 = bfhi(gq.x), g2 = bflo(gq.y), g3 = bfhi(gq.y);
                O[qb][eb][4 * i4 + 0] *= rinv * g0; O[qb][eb][4 * i4 + 1] *= rinv * g1; O[qb][eb][4 * i4 + 2] *= rinv * g2; O[qb][eb][4 * i4 + 3] *= rinv * g3;
                s2 += O[qb][eb][4 * i4 + 0] * O[qb][eb][4 * i4 + 0] + O[qb][eb][4 * i4 + 1] * O[qb][eb][4 * i4 + 1] + O[qb][eb][4 * i4 + 2] * O[qb][eb][4 * i4 + 2] + O[qb][eb][4 * i4 + 3] * O[qb][eb][4 * i4 + 3]; }
        s2 += __shfl_xor(s2, 32);
        if (hh == 0) ssq[h * 128 + 64 * qh + 32 * qb + r] = s2;
    }
    __syncthreads();
#pragma unroll
    for (int qb = 0; qb < 2; ++qb) { const int il = 64 * qh + 32 * qb + r;
        const float tot = ssq[il] + ssq[128 + il] + ssq[256 + il] + ssq[384 + il];
        const float rinv = 1.0f / sqrtf(tot * (1.0f / 256.0f) + EPSN);
        bf16* orow = MIXO + (size_t)(rowbase + il) * DM + 64 * h;
#pragma unroll
        for (int eb = 0; eb < 2; ++eb)
#pragma unroll
            for (int i4 = 0; i4 < 4; ++i4) { const int e = 32 * eb + 8 * i4 + 4 * hh; const f32x4 gg = *(const f32x4*)(g_ret + 64 * h + e);
                v2u o; o.x = pk2(O[qb][eb][4 * i4 + 0] * rinv * gg.x, O[qb][eb][4 * i4 + 1] * rinv * gg.y); o.y = pk2(O[qb][eb][4 * i4 + 2] * rinv * gg.z, O[qb][eb][4 * i4 + 3] * rinv * gg.w);
                *(v2u*)(orow + e) = o; }
    }
}

#define LAS __attribute__((address_space(3)))
#define XB_TMO      128
#define XB_XCNT(j)  (256  + 64 * (j))
#define XB_XSUB(j)  (1280 + 64 * (j))
#define XB_XGEN(j)  (2304 + 64 * (j))
#define XB_TOP      3328
#define XB_TOPGEN   3392
#define XCD_BAR_WORDS 3456
#define XB_SPIN_CAP (1u << 18)

__device__ __forceinline__ unsigned xb_ld(unsigned* p)              { return __hip_atomic_load(p, __ATOMIC_RELAXED, __HIP_MEMORY_SCOPE_AGENT); }
__device__ __forceinline__ unsigned xb_add(unsigned* p, unsigned v) { return __hip_atomic_fetch_add(p, v, __ATOMIC_RELAXED, __HIP_MEMORY_SCOPE_AGENT); }
__device__ __forceinline__ unsigned xb_xcc_id() { return (unsigned)__builtin_amdgcn_s_getreg((3 << 11) | 20) & 0xFu; }
#define XB_SPIN(cond, bar) do { unsigned _sp = 0; while (cond) { __builtin_amdgcn_s_sleep(1); \
    if ((++_sp & 255u) == 0u) { if (xb_ld(&(bar)[XB_TMO])) break; if (_sp > XB_SPIN_CAP) { atomicAdd(&(bar)[XB_TMO], 1u); break; } } } } while (0)

struct XcdBarrier {
    unsigned* bar; unsigned x;
    volatile LAS unsigned* st;
};

__device__ __forceinline__ XcdBarrier xcd_barrier_post(unsigned* bar, volatile LAS unsigned* st) {
    XcdBarrier b; b.bar = bar; b.x = xb_xcc_id(); b.st = st;
    if (threadIdx.x == 0) (void)xb_add(&bar[XB_XCNT(b.x)], 1u);
    return b;
}
__device__ __forceinline__ void xcd_barrier_complete(unsigned* bar, unsigned x, unsigned& nloc, unsigned& nx) {
    const unsigned G = gridDim.x * gridDim.y * gridDim.z;
    unsigned sum, cnt, mine, sp = 0u;
    for (;;) {
        sum = 0u; cnt = 0u; mine = 0u;
#pragma unroll
        for (unsigned j = 0; j < 16; ++j) { const unsigned c = xb_ld(&bar[XB_XCNT(j)]); sum += c; cnt += (c > 0u) ? 1u : 0u; mine = (j == x) ? c : mine; }
        if (sum == G) break;
        __builtin_amdgcn_s_sleep(1);
        if ((++sp & 255u) == 0u) { if (xb_ld(&bar[XB_TMO])) break; if (sp > XB_SPIN_CAP) { atomicAdd(&bar[XB_TMO], 1u); break; } }
    }
    nloc = mine > 0u ? mine : 1u; nx = cnt > 0u ? cnt : 1u;
}

__device__ __forceinline__ void xcd_barrier(const XcdBarrier& b) {
    asm volatile("s_waitcnt vmcnt(0)" ::: "memory");
    __syncthreads();
    if (threadIdx.x == 0) {
        unsigned* bar = b.bar; const unsigned bx = xb_xcc_id();
        __builtin_amdgcn_s_waitcnt(0);
        unsigned nloc = b.st[0], nx = b.st[1];
        if (nloc == 0u) { xcd_barrier_complete(bar, bx, nloc, nx); b.st[0] = nloc; b.st[1] = nx; }
        const unsigned old = xb_add(&bar[XB_XSUB(bx)], 1u);
        const unsigned gen = old / nloc;
        if (old + 1u == (gen + 1u) * nloc) {
            __builtin_amdgcn_fence(__ATOMIC_RELEASE, "agent");
            asm volatile("s_waitcnt vmcnt(0)" ::: "memory");
            const unsigned og = xb_add(&bar[XB_TOP], 1u);
            const unsigned tg = og / nx;
            if (og + 1u == (tg + 1u) * nx) xb_add(&bar[XB_TOPGEN], 1u);
            else XB_SPIN(xb_ld(&bar[XB_TOPGEN]) == tg, bar);
            __builtin_amdgcn_fence(__ATOMIC_ACQUIRE, "agent");
            xb_add(&bar[XB_XGEN(bx)], 1u);
            asm volatile("s_waitcnt vmcnt(0)" ::: "memory");
        } else {
            XB_SPIN(xb_ld(&bar[XB_XGEN(bx)]) == gen, bar);
            __builtin_amdgcn_fence(__ATOMIC_ACQUIRE, "agent");
            asm volatile("s_waitcnt vmcnt(0)" ::: "memory");
        }
    }
    __syncthreads();
}


__global__ void __launch_bounds__(512, 2) mega_fwd(Args a) {
    extern __shared__ __attribute__((aligned(16))) unsigned char lds[];
    cg::grid_group grid = cg::this_grid();
    volatile LAS unsigned* xst = (volatile LAS unsigned*)(lds + LDS_BYTES - 16);
    if (threadIdx.x < 2) xst[threadIdx.x] = 0u;
    if (blockIdx.x == 0) { for (int i = threadIdx.x; i < XCD_BAR_WORDS; i += 512) ((unsigned*)a.ws)[i] = 0u; }
    __syncthreads();
#define GSYNC() xcd_barrier(xbar)
    const int bid = blockIdx.x, G = gridDim.x;
    unsigned char* ws = a.ws;
    bf16* const P = (bf16*)(ws + WS_P); bf16* const MIXO = (bf16*)(ws + WS_MIXO); bf16* const YH = (bf16*)(ws + WS_YH); bf16* const U = (bf16*)(ws + WS_U);
    bf16* const XB = (bf16*)(ws + WS_XB); float* const KV = (float*)(ws + WS_KV); const float* const ADA = (const float*)(ws + WS_ADA);
    unsigned char* const ob = (unsigned char*)a.out;
    bf16* const ZT = (bf16*)(ob + OUT_ZT); bf16* const ZTC = (bf16*)(ob + OUT_ZTC); bf16* const YT = (bf16*)(ob + OUT_YT); bf16* const YTC = (bf16*)(ob + OUT_YTC);

    p0_prologue(a, lds, bid, G);
    grid.sync();
    const XcdBarrier xbar = xcd_barrier_post((unsigned*)a.ws, xst);
    ew_phase(a.in[0], a.in[2], nullptr, nullptr, nullptr, nullptr, nullptr, nullptr, 0, nullptr, YH, ADA, 0, 1024, a.in[6], TT, bid, G);
    GSYNC();

#pragma unroll 1
    for (int l = 0; l < DEPTH; ++l) {
        const bool last = (l == DEPTH - 1);
        const unsigned char* wl = ws + WS_W + (size_t)l * W_LAYER;
        const float* ada_l = ADA + (size_t)l * 33 * 6144;
        const int Mo = last ? TL : TT;
        { pg8::Gemm g{(const pg8::bf16_t*)YH, (const pg8::bf16_t*)(wl + WO_IN), TT, DIN, DM}; pg8::StaticOrder S; S.init(TT, DIN, G, bid);
          pg8::EpiWin E{(pg8::bf16_t*)P, (const float*)(ws + WS_ROTR), (const float*)(ws + WS_ROTA)};
          pg8::gemm_phase<pg8::EpiWin, pg8::StaticOrder, true, true>((PG8_LAS unsigned char*)lds, g, S, E); }
        GSYNC();
        {
            const int nA = 1024 + (last ? 0 : 128), nH = 1024 + (last ? 0 : 128), nR = NB * NCH;
            const float* sw = a.in[13] + (size_t)l * 3 * 768; const float* sbias = a.in[14] + l * 768;
            const int vb = (G & 7) == 0 ? (bid & 7) * (G >> 3) + (bid >> 3) : bid;
            for (int it = vb; it < nA + nH + nR; it += G) {
                if (it < nA) {
                    if (it < 1024) { const int b = 31 - (it >> 5), qb = it & 31; attn_item(P, MIXO, a.in[22] + l * 8, a.in[25] + l * 512, lds, b * SEQ + 64 * qb, 64 * qb, b * SEQ, TL + b * LC, false); }
                    else { const int j = it - 1024, b = j >> 2, qb = j & 3; attn_item(P, MIXO, a.in[22] + l * 8, a.in[25] + l * 512, lds, TL + b * LC + 64 * qb, 0, b * SEQ, TL + b * LC, true); }
                } else if (it < nA + nH) {
                    const int j = it - nA;
                    if (j < 1024) { const int b = 31 - (j >> 5), tb = j & 31; hypre_item(P, sw, sbias, ZT, lds, b * SEQ, b, 64 * tb, SEQ); }
                    else { const int jj = j - 1024, b = jj >> 2, tb = jj & 3; hypre_item(P, sw, sbias, ZTC, lds, TL + b * LC, b, 64 * tb, LC); }
                } else {
                    const int j = it - nA - nH; retkv_mfma_item(P, KV, a.in[11] + l * 4, a.in[12] + l * 4, lds, 31 - j / NCH, j % NCH);
                }
            }
        }
        GSYNC();
        {
            {
            { const int tq = otid(); for (int t = bid * 8 + (tq >> 6); t < NB * 64; t += G * 8) ret_scan_task(KV, a.in[11] + l * 4, a.in[12] + l * 4, t, tq & 63); }
            const int nC = 256, nCc = last ? 0 : 256;
            for (int it = bid; it < nC + nCc; it += G) {
                if (it < nC) hyconv_item<SEQ>(ZT + (size_t)it * 32 * SEQ, (const bf16*)(ws + WS_RF) + ((size_t)l * 256 + it) * 4096, YT + (size_t)it * 32 * SEQ, lds);
                else { const int c = it - nC; hyconv_item<LC>(ZTC + (size_t)c * 32 * LC, (const bf16*)(ws + WS_RC) + ((size_t)l * 256 + c) * 512, YTC + (size_t)c * 32 * LC, lds); }
            } }
        }
        GSYNC();
        {
            const int nRo = NB * (last ? 16 : 18), nH = 1024 + (last ? 0 : 128);
            const float* sw = a.in[13] + (size_t)l * 3 * 768; const float* sbias = a.in[14] + l * 768;
            for (int it = bid; it < nRo + nH; it += G) {
                if (it < nRo) { int b, np; if (last) { b = it >> 4; np = 2 + (it & 15); } else { b = it / 18; np = it % 18; }
                    retout_mfma_item(P, KV, MIXO, a.in[11] + l * 4, a.in[12] + l * 4, a.in[23] + l * 256, lds, b, np); }
                else { const int j = it - nRo;
                    if (j < 1024) { const int b = j >> 5, tb = j & 31; hypost_item(P, sw, sbias, a.in[21] + l * 256, a.in[24] + l * 256, YT, MIXO, lds, b * SEQ, b, 64 * tb, SEQ); }
                    else { const int jj = j - 1024, b = jj >> 2, tb = jj & 3; hypost_item(P, sw, sbias, a.in[21] + l * 256, a.in[24] + l * 256, YTC, MIXO, lds, TL + b * LC, b, 64 * tb, LC); } }
            }
        }
        GSYNC();
        { pg8::Gemm g{(const pg8::bf16_t*)MIXO, (const pg8::bf16_t*)(wl + WO_OUT), Mo, DM, DM}; pg8::StaticOrder S; S.init(Mo, DM, G, bid);
          pg8::EpiBf16<0> E{(pg8::bf16_t*)YH, DM};
          pg8::gemm_phase<pg8::EpiBf16<0>, pg8::StaticOrder, true, true>((PG8_LAS unsigned char*)lds, g, S, E); }
        GSYNC();
        ew_phase(a.in[0], a.in[2], l == 0 ? nullptr : XB, a.out, nullptr, last ? nullptr : XB, YH, ada_l, 2048, a.in[7] + l * DM, YH, ada_l, 3072, 4096, a.in[8] + l * DM, Mo, bid, G);
        GSYNC();
        { pg8::Gemm g{(const pg8::bf16_t*)YH, (const pg8::bf16_t*)(wl + WO_1), Mo, DFF, DM}; pg8::StaticOrder S; S.init(Mo, DFF, G, bid);
          pg8::EpiBf16<1> E{(pg8::bf16_t*)U, DFF};
          pg8::gemm_phase<pg8::EpiBf16<1>, pg8::StaticOrder, true, true>((PG8_LAS unsigned char*)lds, g, S, E); }
        GSYNC();
        { pg8::Gemm g{(const pg8::bf16_t*)U, (const pg8::bf16_t*)(wl + WO_2), Mo, DM, DFF}; pg8::RevOrder S; S.init(Mo, DM, G, bid);
          pg8::EpiBf16<0> E{(pg8::bf16_t*)YH, DM};
          pg8::gemm_phase<pg8::EpiBf16<0>, pg8::RevOrder, true, true>((PG8_LAS unsigned char*)lds, g, S, E); }
        GSYNC();
        ew_phase(a.out, nullptr, last ? nullptr : XB, a.out, nullptr, last ? nullptr : XB, YH, ada_l, 5120, a.in[9] + l * DM, last ? nullptr : YH, ada_l + 33 * 6144, 0, 1024, a.in[6] + (last ? 0 : (l + 1) * DM), Mo, bid, G);
        if (!last) GSYNC();
    }
}

extern "C" void kernel_launch(void* const* d_in, const int* in_sizes, int n_in, void* d_out, int out_size, void* d_ws, size_t ws_size, hipStream_t stream) {
    static int grid = 0;
    if (grid == 0) {
        if (n_in != 29 || out_size != TL * DM || ws_size < WS_END) { fprintf(stderr, "kernel_launch: unexpected shapes (n_in %d out %d ws %zu)\n", n_in, out_size, ws_size); grid = -1; return; }
        int dev = 0, cus = 0, per_cu = 0;
        hipGetDevice(&dev); hipDeviceGetAttribute(&cus, hipDeviceAttributeMultiprocessorCount, dev);
        if (hipFuncSetAttribute((const void*)mega_fwd, hipFuncAttributeMaxDynamicSharedMemorySize, LDS_BYTES) != hipSuccess) { fprintf(stderr, "kernel_launch: hipFuncSetAttribute failed\n"); grid = -1; return; }
        if (hipOccupancyMaxActiveBlocksPerMultiprocessor(&per_cu, (const void*)mega_fwd, 512, LDS_BYTES) != hipSuccess || per_cu < 1) { fprintf(stderr, "kernel_launch: occupancy query failed (%d)\n", per_cu); per_cu = 1; }
        (void)hipGetLastError();
        grid = cus * per_cu;
    }
    if (grid < 0) return;
    Args a{};
    for (int i = 0; i < 29; ++i) a.in[i] = (const float*)d_in[i];
    a.out = (float*)d_out; a.ws = (unsigned char*)d_ws;
    void* args[] = {&a};
    hipError_t e = hipLaunchCooperativeKernel((const void*)mega_fwd, dim3(grid), dim3(512), args, LDS_BYTES, stream);
    if (e != hipSuccess) fprintf(stderr, "kernel_launch: cooperative launch failed: %s (grid %d)\n", hipGetErrorString(e), grid);
}
```

```cpp
#include <hip/hip_runtime.h>
#include <hip/hip_cooperative_groups.h>
#include <cstdio>
#include <cstdint>
namespace cg = cooperative_groups;
#include <hip/hip_runtime.h>
namespace pg8 {
#define PG8_LAS __attribute__((address_space(3)))
typedef unsigned short bf16_t;
typedef short bf16x8 __attribute__((ext_vector_type(8)));
typedef float f32x4 __attribute__((ext_vector_type(4)));
typedef unsigned u32x4 __attribute__((ext_vector_type(4)));
constexpr int BM = 256, BK = 64, HALF = 128, HTB = HALF * BK * 2  , STAGE_BYTES = 8 * HTB, NXCD = 8, WGM = 8;

__host__ __device__ __forceinline__ int lds_byte(int r, int c) { const int st = (r >> 4) * 2 + (c >> 5), rr = r & 15, cc = c & 31, ob = rr * 64 + cc * 2; return st * 1024 + (ob ^ (((ob >> 9) & 1) << 5)); }
__host__ __device__ __forceinline__ void stage_rc(int b, int& R, int& C) { const int st = b / 1024, sb = b % 1024, swz = sb ^ (((sb >> 9) & 1) << 5); R = (st >> 1) * 16 + swz / 64; C = (st & 1) * 32 + (swz % 64) / 2; }
__host__ __device__ __forceinline__ int perm32(int rho) { const int n = rho >> 4, i = rho & 15; return 8 * (i >> 2) + 4 * n + (i & 3); }

struct Unit { int pm, pn; };
struct Gemm { const bf16_t* A; const bf16_t* Bt; int M, N, K; };

struct StaticOrder {
    int nM, nN, nwg, G, c;
    __host__ __device__ void init(int M, int N, int G_, int c_) { nM = M / BM; nN = N / BM; nwg = nM * nN; G = G_; c = c_; }
    __host__ __device__ bool next(int i, Unit& u) const {
        const long L = (long)i * G + c; if (L >= nwg) return false;
        int wgid = (int)L; { const int q = nwg / NXCD, r = nwg % NXCD, xcd = wgid % NXCD, off = wgid / NXCD; wgid = (xcd < r ? xcd * (q + 1) : r * (q + 1) + (xcd - r) * q) + off; }
        const int nig = WGM * nN, gid = wgid / nig, fm = gid * WGM, gsz = (nM - fm) < WGM ? (nM - fm) : WGM;
        u.pm = fm + ((wgid % nig) % gsz); u.pn = (wgid % nig) / gsz; return true;
    }
    __device__ __forceinline__ void a_ready(const Unit&) const {}
    __device__ __forceinline__ void done(const Unit&) const {}
};

struct RevOrder : StaticOrder {
    __host__ __device__ bool next(int i, Unit& u) const { if (!StaticOrder::next(i, u)) return false; u.pm = nM - 1 - u.pm; return true; }
};
__device__ __forceinline__ unsigned cvt_pk_bf16(float lo, float hi) { unsigned r; asm volatile("v_cvt_pk_bf16_f32 %0, %1, %2" : "=v"(r) : "v"(lo), "v"(hi)); return r; }
typedef unsigned u32x2 __attribute__((ext_vector_type(2)));

template <int ACT  > struct EpiBf16 {
    static constexpr bool PERM = true, AFTER_DRAIN = false;
    bf16_t* O; int ldc;
    __device__ __forceinline__ void operator()(const f32x4 (&acc)[2][2][4][2], const Unit& u, int wr, int wc, int fr, int fq) const {
        const int row0 = u.pm * BM + wr * 64 + fr; const int col0 = u.pn * BM + wc * 32 + 8 * fq;
#pragma unroll
        for (int ai = 0; ai < 2; ++ai)
#pragma unroll
            for (int m = 0; m < 4; ++m) { bf16_t* rowp = O + (size_t)(row0 + ai * HALF + m * 16) * ldc + col0;
#pragma unroll
                for (int bj = 0; bj < 2; ++bj) { f32x4 v0 = acc[ai][bj][m][0], v1 = acc[ai][bj][m][1];
                    if (ACT == 1) {
#pragma unroll
                        for (int j = 0; j < 4; ++j) { const float a = fmaxf(v0[j], 0.f), b = fmaxf(v1[j], 0.f); v0[j] = a * a; v1[j] = b * b; } }
                    u32x4 w; w.x = cvt_pk_bf16(v0[0], v0[1]); w.y = cvt_pk_bf16(v0[2], v0[3]); w.z = cvt_pk_bf16(v1[0], v1[1]); w.w = cvt_pk_bf16(v1[2], v1[3]);
                    *(u32x4*)(rowp + bj * HALF) = w; } }
    }
};

struct EpiWin {
    static constexpr bool PERM = false, AFTER_DRAIN = false;
    bf16_t* P; const float* rot_ret; const float* rot_ax;
    __device__ __forceinline__ void operator()(const f32x4 (&acc)[2][2][4][2], const Unit& u, int wr, int wc, int fr, int fq) const {
        const int row0 = u.pm * BM + wr * 64 + fr; const bool latent = (u.pm < 256); const int pn = u.pn;
#pragma unroll
        for (int ai = 0; ai < 2; ++ai)
#pragma unroll
            for (int m = 0; m < 4; ++m) { const int row = row0 + ai * HALF + m * 16; const int pos = row & 2047;
                bf16_t* rowp = P + (size_t)row * 2304 + pn * BM + wc * 32 + 4 * fq;
#pragma unroll
                for (int bj = 0; bj < 2; ++bj) { f32x4 v0 = acc[ai][bj][m][0], v1 = acc[ai][bj][m][1];
                    int mode = 0; float post = 1.f; const float* tab = rot_ret;
                    if (pn == 0) { mode = latent ? 1 : 0; tab = rot_ret + pos * 32 + 4 * fq; if (bj == 1) post = 0.17677669529663687f; }
                    else if (pn == 2) mode = 2;
                    else if (pn == 6 || pn == 7) { mode = latent ? 1 : 0; tab = rot_ax + pos * 64 + (wc & 1) * 32 + 4 * fq; post = 0.125f * 1.4426950408889634f; }
                    else if (pn == 8 && bj == 0) { mode = latent ? 1 : 0; tab = rot_ax + pos * 64 + (wc & 1) * 32 + 4 * fq; }
                    if (mode == 1) { const f32x4 c = *(const f32x4*)tab, s = *(const f32x4*)(tab + 16);
                        const f32x4 o0 = v0 * c - v1 * s, o1 = v1 * c + v0 * s; v0 = o0; v1 = o1; }
                    if (mode == 2) {
#pragma unroll
                        for (int j = 0; j < 4; ++j) { v0[j] = v0[j] / (1.f + __expf(-v0[j])); v1[j] = v1[j] / (1.f + __expf(-v1[j])); } }
                    v0 = v0 * post; v1 = v1 * post;
                    u32x2 w0, w1; w0.x = cvt_pk_bf16(v0[0], v0[1]); w0.y = cvt_pk_bf16(v0[2], v0[3]); w1.x = cvt_pk_bf16(v1[0], v1[1]); w1.y = cvt_pk_bf16(v1[2], v1[3]);
                    *(u32x2*)(rowp + bj * HALF) = w0; *(u32x2*)(rowp + bj * HALF + 16) = w1; } }
    }
};

template <class Epi, class Sched, bool ALIGN_EPI = false, bool SP2 = false>
__device__ __forceinline__ void gemm_phase(PG8_LAS unsigned char* lds, const Gemm g, const Sched& S, const Epi& E) {
    int tid_ = threadIdx.x; asm volatile("" : "+v"(tid_));
    const int tid = tid_, wid = __builtin_amdgcn_readfirstlane(tid >> 6), lane = tid & 63, wr = wid >> 2, wc = wid & 3, fr = lane & 15, fq = lane >> 4;
    const int K = g.K, nt = K / BK;
    unsigned voffA[2], voffB[2];
#pragma unroll
    for (int i = 0; i < 2; ++i) { int R, C; stage_rc(tid * 16 + i * 8192, R, C); const int Rb = Epi::PERM ? ((R & ~31) + perm32(R & 31)) : R;
        voffA[i] = (unsigned)(R * K + C) * 2u; voffB[i] = (unsigned)(Rb * K + C) * 2u; }
    const size_t kstep = (size_t)(BK * 2);
    const size_t hstep = (size_t)HALF * K * 2;
    const size_t tstep = 2 * hstep;
    const unsigned ldsw = (unsigned)wid * 1024u;
    const int aoff = lds_byte(wr * 64 + fr, fq * 8), boff = lds_byte(wc * 32 + fr, fq * 8);
#define PG8_SA(b, h) (((b) * 2 + (h)) * HTB)
#define PG8_SB(b, h) ((4 + (b) * 2 + (h)) * HTB)
#define PG8_STAGE(bufoff, gbase, voff) do { _Pragma("unroll") for (int _i = 0; _i < 2; ++_i) \
        __builtin_amdgcn_global_load_lds((const unsigned*)((const char*)(gbase) + (voff)[_i]), (PG8_LAS unsigned*)(lds + (bufoff) + ldsw + _i * 8192), 16, 0, 0); } while (0)
#define PG8_LDA(dst, b, h) do { _Pragma("unroll") for (int m = 0; m < 4; ++m) _Pragma("unroll") for (int k = 0; k < 2; ++k) dst[m][k] = *(const PG8_LAS bf16x8*)(lds + PG8_SA(b, h) + aoff + m * 2048 + k * 1024); } while (0)
#define PG8_LDB(dst, b, h) do { _Pragma("unroll") for (int n = 0; n < 2; ++n) _Pragma("unroll") for (int k = 0; k < 2; ++k) dst[n][k] = *(const PG8_LAS bf16x8*)(lds + PG8_SB(b, h) + boff + n * 2048 + k * 1024); } while (0)
#define PG8_MMA(ai, bj, At, Bt) do { __builtin_amdgcn_s_setprio(1); _Pragma("unroll") for (int m = 0; m < 4; ++m) _Pragma("unroll") for (int n = 0; n < 2; ++n) _Pragma("unroll") for (int k = 0; k < 2; ++k) \
        acc[ai][bj][m][n] = __builtin_amdgcn_mfma_f32_16x16x32_bf16(Bt[n][k], At[m][k], acc[ai][bj][m][n], 0, 0, 0); __builtin_amdgcn_s_setprio(0); } while (0)
#define PG8_WAIT_V(n) asm volatile("s_waitcnt vmcnt(" #n ")" ::: "memory")
#define PG8_WAIT_L(n) asm volatile("s_waitcnt lgkmcnt(" #n ")" ::: "memory")
#define PG8_BAR __builtin_amdgcn_s_barrier()
#define PG8_SCHED __builtin_amdgcn_sched_barrier(0)
    Unit cur, nxt; int ui = 0;
    if (!S.next(0, cur)) return;
    f32x4 acc[2][2][4][2];
#pragma unroll
    for (int a = 0; a < 2; ++a)
#pragma unroll
        for (int b = 0; b < 2; ++b)
#pragma unroll
            for (int m = 0; m < 4; ++m)
#pragma unroll
                for (int n = 0; n < 2; ++n) acc[a][b][m][n] = (f32x4){0.f, 0.f, 0.f, 0.f};
    bf16x8 At[4][2], B0[2][2], B1[2][2];
    const char* cA = (const char*)g.A + (size_t)cur.pm * tstep; const char* cB = (const char*)g.Bt + (size_t)cur.pn * tstep;
    S.a_ready(cur);
    if constexpr (SP2) {
        PG8_STAGE(PG8_SB(0, 0), cB, voffB); PG8_STAGE(PG8_SB(0, 1), cB + hstep, voffB); PG8_STAGE(PG8_SA(0, 0), cA, voffA); PG8_STAGE(PG8_SA(0, 1), cA + hstep, voffA);
        if (wr == 1) PG8_BAR;
        PG8_WAIT_V(2); PG8_BAR;
        PG8_STAGE(PG8_SB(1, 0), cB + kstep, voffB); PG8_STAGE(PG8_SA(1, 0), cA + kstep, voffA); PG8_STAGE(PG8_SB(1, 1), cB + hstep + kstep, voffB);
        PG8_WAIT_V(6); PG8_BAR;
    } else {
        PG8_STAGE(PG8_SB(0, 0), cB, voffB); PG8_STAGE(PG8_SA(0, 0), cA, voffA); PG8_STAGE(PG8_SB(0, 1), cB + hstep, voffB); PG8_STAGE(PG8_SA(0, 1), cA + hstep, voffA);
        if (wr == 1) PG8_BAR;
        PG8_WAIT_V(4); PG8_BAR;
        PG8_STAGE(PG8_SB(1, 0), cB + kstep, voffB); PG8_STAGE(PG8_SA(1, 0), cA + kstep, voffA); PG8_STAGE(PG8_SB(1, 1), cB + hstep + kstep, voffB);
        PG8_WAIT_V(6); PG8_BAR;
    }
    for (;;) {
        const bool has_next = S.next(ui + 1, nxt);
        const char* nA = has_next ? (const char*)g.A + (size_t)nxt.pm * tstep : cA; const char* nB = has_next ? (const char*)g.Bt + (size_t)nxt.pn * tstep : cB;
        for (int t = 0; t < nt; t += 2) {
            const bool last = (t == nt - 2);
            const char* a1 = cA + (size_t)(t + 1) * kstep;
            const char* a2 = last ? nA : cA + (size_t)(t + 2) * kstep; const char* b2 = last ? nB : cB + (size_t)(t + 2) * kstep;
            const char* a3 = a2 + kstep; const char* b3 = b2 + kstep;
            if (last && has_next) S.a_ready(nxt);
            if constexpr (SP2) {
            PG8_LDB(B0, 0, 0); PG8_LDB(B1, 0, 1); PG8_SCHED; PG8_LDA(At, 0, 0); PG8_STAGE(PG8_SA(1, 1), a1 + hstep, voffA);
            PG8_WAIT_V(8); PG8_WAIT_L(0); PG8_BAR; PG8_MMA(0, 0, At, B0); PG8_MMA(0, 1, At, B1); PG8_BAR; PG8_SCHED;
            PG8_LDA(At, 0, 1); PG8_STAGE(PG8_SB(0, 0), b2, voffB); PG8_STAGE(PG8_SB(0, 1), b2 + hstep, voffB); PG8_STAGE(PG8_SA(0, 0), a2, voffA);
            PG8_WAIT_V(8); PG8_WAIT_L(0); PG8_BAR; PG8_MMA(1, 0, At, B0); PG8_MMA(1, 1, At, B1); PG8_BAR; PG8_SCHED;
            PG8_LDB(B0, 1, 0); PG8_LDB(B1, 1, 1); PG8_SCHED; PG8_LDA(At, 1, 0); PG8_STAGE(PG8_SA(0, 1), a2 + hstep, voffA);
            PG8_WAIT_V(8); PG8_WAIT_L(0); PG8_BAR; PG8_MMA(0, 0, At, B0); PG8_MMA(0, 1, At, B1); PG8_BAR; PG8_SCHED;
            PG8_LDA(At, 1, 1); PG8_STAGE(PG8_SB(1, 0), b3, voffB); PG8_STAGE(PG8_SB(1, 1), b3 + hstep, voffB); PG8_STAGE(PG8_SA(1, 0), a3, voffA);
            PG8_WAIT_V(8); PG8_WAIT_L(0); PG8_BAR; PG8_MMA(1, 0, At, B0); PG8_MMA(1, 1, At, B1); PG8_BAR; PG8_SCHED;
            } else {
            PG8_LDB(B0, 0, 0); PG8_SCHED; PG8_LDA(At, 0, 0); PG8_STAGE(PG8_SA(1, 1), a1 + hstep, voffA);
            PG8_WAIT_L(8); PG8_BAR; PG8_WAIT_L(0); PG8_MMA(0, 0, At, B0); PG8_BAR; PG8_SCHED;
            PG8_LDB(B1, 0, 1); PG8_STAGE(PG8_SB(0, 0), b2, voffB);
            PG8_BAR; PG8_WAIT_L(0); PG8_MMA(0, 1, At, B1); PG8_BAR;
            PG8_LDA(At, 0, 1); PG8_STAGE(PG8_SA(0, 0), a2, voffA);
            PG8_BAR; PG8_WAIT_L(0); PG8_MMA(1, 0, At, B0); PG8_BAR; PG8_SCHED;
            PG8_STAGE(PG8_SB(0, 1), b2 + hstep, voffB);
            PG8_WAIT_V(6); PG8_BAR; PG8_MMA(1, 1, At, B1); PG8_BAR;
            PG8_LDB(B0, 1, 0); PG8_SCHED; PG8_LDA(At, 1, 0); PG8_STAGE(PG8_SA(0, 1), a2 + hstep, voffA);
            PG8_WAIT_L(8); PG8_BAR; PG8_WAIT_L(0); PG8_MMA(0, 0, At, B0); PG8_BAR; PG8_SCHED;
            PG8_LDB(B1, 1, 1); PG8_STAGE(PG8_SB(1, 0), b3, voffB);
            PG8_BAR; PG8_WAIT_L(0); PG8_MMA(0, 1, At, B1); PG8_BAR;
            PG8_LDA(At, 1, 1); PG8_STAGE(PG8_SA(1, 0), a3, voffA);
            PG8_BAR; PG8_WAIT_L(0); PG8_MMA(1, 0, At, B0); PG8_BAR; PG8_SCHED;
            PG8_STAGE(PG8_SB(1, 1), b3 + hstep, voffB);
            PG8_WAIT_V(6); PG8_BAR; PG8_MMA(1, 1, At, B1); PG8_BAR;
            }
        }
        if constexpr (ALIGN_EPI) { if (wr == 0) PG8_BAR; }
        if constexpr (!Epi::AFTER_DRAIN) { E(acc, cur, wr, wc, fr, fq); S.done(cur); }
        if (!has_next) break;
#pragma unroll
        for (int a = 0; a < 2; ++a)
#pragma unroll
            for (int b = 0; b < 2; ++b)
#pragma unroll
                for (int m = 0; m < 4; ++m)
#pragma unroll
                    for (int n = 0; n < 2; ++n) acc[a][b][m][n] = (f32x4){0.f, 0.f, 0.f, 0.f};
        cur = nxt; cA = nA; cB = nB; ++ui;
        if constexpr (ALIGN_EPI) { if (wr == 1) PG8_BAR; }
    }
    PG8_WAIT_V(0);
    if constexpr (!ALIGN_EPI) { if (wr == 0) PG8_BAR; }
    PG8_BAR;
    if constexpr (Epi::AFTER_DRAIN) { E.fused(acc, cur, wr, wc, fr, fq, lds, wid, lane); S.done(cur); }
#undef PG8_SA
#undef PG8_SB
#undef PG8_STAGE
#undef PG8_LDA
#undef PG8_LDB
#undef PG8_MMA
#undef PG8_WAIT_V
#undef PG8_WAIT_L
#undef PG8_BAR
#undef PG8_SCHED
}
}
constexpr int DM = 1024, NB = 32, SEQ = 2048, DEPTH = 4, LC = 256;
constexpr int TL = NB * SEQ, TC = NB * LC, TT = TL + TC;
constexpr int DIN = 2304, DFF = 4096;
constexpr int C_RQ = 0, C_RK = 128, C_RV = 256, C_RG = 512, C_HY = 768, C_AQ = 1536, C_AK = 2048, C_AV = 2176;
constexpr float EPSN = 1e-6f, LOG2E = 1.4426950408889634f;
constexpr int NCH = 18;

constexpr size_t MiB = 1u << 20;
constexpr size_t WS_W = 2 * MiB, W_LAYER = (size_t)(2304 + 1024 + 4096 + 4096) * 1024 * 2;
constexpr size_t WO_IN = 0, WO_OUT = (size_t)2304 * 1024 * 2, WO_1 = WO_OUT + (size_t)1024 * 1024 * 2, WO_2 = WO_1 + (size_t)4096 * 1024 * 2;
constexpr size_t WS_ADA = 92 * MiB, WS_ROTR = 96 * MiB, WS_ROTA = 97 * MiB, WS_RF = 98 * MiB, WS_RC = 106 * MiB, WS_KV = 864 * MiB;
constexpr size_t OUT_ZT = 0 * MiB, OUT_ZTC = 32 * MiB, OUT_YT = 36 * MiB, OUT_YTC = 68 * MiB;
constexpr size_t WS_XB = 108 * MiB, WS_YH = 252 * MiB;
constexpr size_t WS_P = 396 * MiB, WS_MIXO = 720 * MiB, WS_U = 396 * MiB, WS_END = 972 * MiB;
constexpr int LDS_BYTES = 150 * 1024;

typedef unsigned short bf16;
typedef unsigned v4u __attribute__((ext_vector_type(4)));
typedef unsigned v2u __attribute__((ext_vector_type(2)));
typedef float f32x4 __attribute__((ext_vector_type(4)));
typedef float f32x16 __attribute__((ext_vector_type(16)));
typedef short bf16x8 __attribute__((ext_vector_type(8)));
typedef short s16x4 __attribute__((ext_vector_type(4)));
#define MFMA32(a, b, c) __builtin_amdgcn_mfma_f32_32x32x16_bf16((a), (b), (c), 0, 0, 0)
#define DI __device__ __forceinline__

DI unsigned f2bf(float f) { unsigned u = __builtin_bit_cast(unsigned, f); return (u + 0x7fffu + ((u >> 16) & 1u)) >> 16; }
typedef float f32x2_t __attribute__((ext_vector_type(2)));
typedef __bf16 bf16x2_t __attribute__((ext_vector_type(2)));
DI unsigned pk2(float lo, float hi) { const f32x2_t v = {lo, hi}; return __builtin_bit_cast(unsigned, __builtin_convertvector(v, bf16x2_t)); }
DI float bf2f(bf16 b) { return __builtin_bit_cast(float, (unsigned)b << 16); }
DI float bflo(unsigned w) { return __builtin_bit_cast(float, w << 16); }
DI float bfhi(unsigned w) { return __builtin_bit_cast(float, w & 0xffff0000u); }
template <int CTRL> DI float dpp_mov(float v) { return __builtin_bit_cast(float, __builtin_amdgcn_update_dpp(0, __builtin_bit_cast(int, v), CTRL, 0xf, 0xf, true)); }
DI float wave_sum(float v) {
    v += dpp_mov<0xB1>(v); v += dpp_mov<0x4E>(v); v += dpp_mov<0x141>(v); v += dpp_mov<0x140>(v);
    v += __shfl_xor(v, 16); v += __shfl_xor(v, 32);
    return v;
}
DI float rdlane(float v, int l) { return __builtin_bit_cast(float, __builtin_amdgcn_readlane(__builtin_bit_cast(int, v), l)); }

DI int otid() { int t = threadIdx.x; asm volatile("" : "+v"(t)); return t; }
DI size_t ozero() { size_t z = 0; asm volatile("" : "+s"(z)); return z; }
DI unsigned ozero32() { unsigned z = 0; asm volatile("" : "+s"(z)); return z; }
struct Args { const float* in[29]; float* out; unsigned char* ws; };

DI void p0_transpose_item(const float* W, int K, int N, bf16* WT, float* scr, int item, int lane) {
    const int nblk = N / 32, kb = item / nblk, nb = item % nblk, k0 = 64 * kb, n0 = 32 * nb;
    float wv[32];
#pragma unroll
    for (int i = 0; i < 32; ++i) wv[i] = W[(size_t)(k0 + 2 * i + (lane >> 5)) * N + n0 + (lane & 31)];
#pragma unroll
    for (int i = 0; i < 32; ++i) scr[(2 * i + (lane >> 5)) * 33 + (lane & 31)] = wv[i];
    asm volatile("s_waitcnt lgkmcnt(0)" ::: "memory");
    const int c = lane & 7;
#pragma unroll
    for (int j = 0; j < 4; ++j) { const int n = (lane >> 3) + 8 * j; const float* s = scr + (8 * c) * 33 + n;
        v4u o; o.x = pk2(s[0 * 33], s[1 * 33]); o.y = pk2(s[2 * 33], s[3 * 33]); o.z = pk2(s[4 * 33], s[5 * 33]); o.w = pk2(s[6 * 33], s[7 * 33]);
        *(v4u*)(WT + (size_t)(n0 + n) * K + k0 + 8 * c) = o; }
    asm volatile("s_waitcnt lgkmcnt(0)" ::: "memory");
}

DI void p0_prologue(const Args& a, unsigned char* lds, int bid, int G) {
    const int tid = otid(), lane = tid & 63, wave = tid >> 6;
    const int gw = bid * 8 + wave, NGW = G * 8;
    unsigned char* ws = a.ws;
#pragma unroll 1
    for (int ph = 0; ph < 2; ++ph) {
    if (((wave & 1) == 0) == (ph == 0)) {
    {
        float* scr = (float*)(lds + wave * 16384);
        constexpr int I_IN = 16 * 72, I_OUT = 16 * 32, I_1 = 16 * 128, I_2 = 64 * 32, I_L = I_IN + I_OUT + I_1 + I_2;
        for (int it = gw; it < DEPTH * I_L; it += NGW) {
            const int l = it / I_L; int r = it % I_L; unsigned char* wl = ws + WS_W + (size_t)l * W_LAYER;
            if (r < I_IN) { p0_transpose_item(a.in[10] + (size_t)l * 1024 * 2304, 1024, 2304, (bf16*)(wl + WO_IN), scr, r, lane); continue; } r -= I_IN;
            if (r < I_OUT) { p0_transpose_item(a.in[26] + (size_t)l * 1024 * 1024, 1024, 1024, (bf16*)(wl + WO_OUT), scr, r, lane); continue; } r -= I_OUT;
            if (r < I_1) { p0_transpose_item(a.in[27] + (size_t)l * 1024 * 4096, 1024, 4096, (bf16*)(wl + WO_1), scr, r, lane); continue; } r -= I_1;
            p0_transpose_item(a.in[28] + (size_t)l * 4096 * 1024, 4096, 1024, (bf16*)(wl + WO_2), scr, r, lane);
        }
    }
    } else {
    {
        for (int it = gw; it < DEPTH * 2304; it += NGW) {
            const int l = it / 2304, rp = it % 2304; const int LQ = rp < 2048 ? 2048 : 256; const int p = rp < 2048 ? rp : rp - 2048;
            const float* w1 = a.in[15] + (size_t)l * 33 * 64; const float* b1 = a.in[16] + l * 64; const float* w2 = a.in[17] + (size_t)l * 2 * 64 * 64; const float* b2 = a.in[18] + l * 2 * 64;
            const float* w3 = a.in[19] + (size_t)l * 64 * 512; const float fr = a.in[20][l * 64 + lane];
            const float t = (float)p / (float)(LQ - 1); const float w = 6.283185307179586f * (float)p / (float)LQ;
            float zval = 0.f;
            if (lane == 0) zval = t;
            else if (lane <= 32) { const int bi = (lane - 1) & 15; const float band = 1e-4f + (float)bi * ((15.0f - 1e-4f) / 15.0f); const float ang = w * band; zval = lane <= 16 ? cosf(ang) : -sinf(ang); }
            float acc = b1[lane];
#pragma unroll
            for (int e = 0; e < 33; ++e) acc += rdlane(zval, e) * w1[e * 64 + lane];
            float h = sinf(fr * acc);
#pragma unroll 1
            for (int jj = 0; jj < 2; ++jj) { acc = b2[jj * 64 + lane];
#pragma unroll
                for (int i = 0; i < 64; ++i) acc += rdlane(h, i) * w2[(jj * 64 + i) * 64 + lane];
                h = sinf(fr * acc); }
            bf16* R = (LQ == 2048) ? (bf16*)(ws + WS_RF) + ((size_t)l * 256) * 4096 : (bf16*)(ws + WS_RC) + ((size_t)l * 256) * 512;
            const int RS = 2 * LQ;
#pragma unroll 1
            for (int o = 0; o < 8; ++o) { const int col = lane + 64 * o; float s = 0.f;
#pragma unroll
                for (int i = 0; i < 64; ++i) s += rdlane(h, i) * w3[i * 512 + col];
                const int c = col & 255; const float delta = 3.0701134573253945f + (float)c * ((15.350567286626973f - 3.0701134573253945f) / 255.0f);
                const float val = s * expf(-t * delta);
                if (col < 256) R[(size_t)c * RS + (LQ - 1 - p)] = (bf16)f2bf(val);
                else if (p >= 1) R[(size_t)c * RS + (LQ - 1 + p)] = (bf16)f2bf(val); }
            if (p == 0) { for (int c = lane; c < 256; c += 64) R[(size_t)c * RS + RS - 1] = 0; }
        }
    }
    }
    }
    {
        float* rotr = (float*)(ws + WS_ROTR); float* rota = (float*)(ws + WS_ROTA);
        for (int i = bid * 512 + tid; i < 2048 * 16; i += G * 512) { const int pos = i >> 4, f = i & 15;
            const float invr = 1.0f / powf(10000.0f, (float)f / 15.0f); const float ang = (float)pos * invr;
            rotr[pos * 32 + f] = cosf(ang); rotr[pos * 32 + 16 + f] = sinf(ang);
            const float inva = powf(10000.0f, -(float)f / 16.0f); const float ar = (float)(pos >> 6) * inva, ac = (float)(pos & 63) * inva;
            rota[pos * 64 + f] = cosf(ar); rota[pos * 64 + 16 + f] = sinf(ar); rota[pos * 64 + 32 + f] = cosf(ac); rota[pos * 64 + 48 + f] = sinf(ac); }
    }
    __syncthreads();
    {
        float* sil = (float*)lds + wave * (33 * 64);
        float* red = (float*)lds + 8 * 33 * 64;
        float* ada = (float*)(ws + WS_ADA);
        for (int it = bid; it < DEPTH * 96; it += G) {
            const int l = it / 96, n0 = (it % 96) * 64;
            const float* wa = a.in[4] + (size_t)l * 1024 * 6144;
            float acc[33];
#pragma unroll
            for (int b = 0; b < 33; ++b) acc[b] = 0.f;
#pragma unroll 1
            for (int kc = 0; kc < 2; ++kc) { const int k0 = wave * 128 + kc * 64;
#pragma unroll 1
                for (int b = 0; b < 33; ++b) { const float cv = b < 32 ? a.in[1][b * 1024 + k0 + lane] : a.in[3][k0 + lane]; sil[b * 64 + lane] = cv / (1.f + expf(-cv)); }
                asm volatile("s_waitcnt lgkmcnt(0)" ::: "memory");
#pragma unroll 4
                for (int kk = 0; kk < 64; ++kk) { const float wv = wa[(size_t)(k0 + kk) * 6144 + n0 + lane];
#pragma unroll
                    for (int b = 0; b < 33; ++b) acc[b] += sil[b * 64 + kk] * wv; }
                asm volatile("s_waitcnt lgkmcnt(0)" ::: "memory");
            }
#pragma unroll
            for (int b = 0; b < 33; ++b) red[(wave * 33 + b) * 64 + lane] = acc[b];
            __syncthreads();
            for (int o = tid; o < 33 * 64; o += 512) { float s = a.in[5][l * 6144 + n0 + (o & 63)];
#pragma unroll
                for (int w8 = 0; w8 < 8; ++w8) s += red[w8 * 33 * 64 + o];
                ada[((size_t)l * 33 + (o >> 6)) * 6144 + n0 + (o & 63)] = s; }
            __syncthreads();
        }
    }
}

DI void ew_phase(const float* xin_lat, const float* xin_ctx, const bf16* xin_b, float* xout_lat, float* xout_ctx, bf16* xout_b, const bf16* Y, const float* ada_g, int goff, const float* g_post,
                 bf16* H, const float* ada_h, int shoff, int scoff, const float* g_pre, int nrows, int bid, int G) {
    const int tid = otid(); const int lane = tid & 63, wave = tid >> 6;
    const int perb = (nrows + G - 1) / G; const int r0 = bid * perb + wave, r1 = min(nrows, (bid + 1) * perb);
    f32x4 gpo[4], gpr[4], gt[4], sh[4], sc[4];
#pragma unroll
    for (int j = 0; j < 4; ++j) { gpo[j] = Y ? *(const f32x4*)(g_post + 4 * lane + 256 * j) : (f32x4){0.f, 0.f, 0.f, 0.f}; gpr[j] = H ? *(const f32x4*)(g_pre + 4 * lane + 256 * j) : (f32x4){0.f, 0.f, 0.f, 0.f};
        gt[j] = (f32x4){0.f, 0.f, 0.f, 0.f}; sh[j] = gt[j]; sc[j] = gt[j]; }
    int curb = -1;
#pragma unroll 1
    for (int r = r0; r < r1; r += 8) {
        const bool lat = r < TL; const int b = lat ? (r >> 11) : 32;
        f32x4 v[4];
        if (xin_b) {
#pragma unroll
            for (int j = 0; j < 4; ++j) { const v2u w = __builtin_nontemporal_load((const v2u*)(xin_b + (size_t)r * DM + 4 * lane + 256 * j)); v[j] = (f32x4){bflo(w.x), bfhi(w.x), bflo(w.y), bfhi(w.y)}; }
        } else { const float* xr = lat ? xin_lat + (size_t)r * DM : xin_ctx + (size_t)(r - TL) * DM;
#pragma unroll
            for (int j = 0; j < 4; ++j) v[j] = *(const f32x4*)(xr + 4 * lane + 256 * j); }
        v2u yw[4];
        if (Y) {
#pragma unroll
            for (int j = 0; j < 4; ++j) yw[j] = __builtin_nontemporal_load((const v2u*)(Y + (size_t)r * DM + 4 * lane + 256 * j));
        }
        if (b != curb) { curb = b;
#pragma unroll
            for (int j = 0; j < 4; ++j) { if (Y) gt[j] = *(const f32x4*)(ada_g + (size_t)b * 6144 + goff + 4 * lane + 256 * j);
                if (H) { sh[j] = *(const f32x4*)(ada_h + (size_t)b * 6144 + shoff + 4 * lane + 256 * j); sc[j] = *(const f32x4*)(ada_h + (size_t)b * 6144 + scoff + 4 * lane + 256 * j) + 1.0f; } } }
        if (Y) {
            f32x4 y[4]; float ss = 0.f;
#pragma unroll
            for (int j = 0; j < 4; ++j) { y[j] = (f32x4){bflo(yw[j].x), bfhi(yw[j].x), bflo(yw[j].y), bfhi(yw[j].y)};
                ss += y[j].x * y[j].x + y[j].y * y[j].y + y[j].z * y[j].z + y[j].w * y[j].w; }
            const float rinv = 1.0f / sqrtf(wave_sum(ss) * (1.0f / DM) + EPSN);
#pragma unroll
            for (int j = 0; j < 4; ++j) v[j] = v[j] + gt[j] * (y[j] * rinv * gpo[j]);
            if (xout_b) {
#pragma unroll
                for (int j = 0; j < 4; ++j) { v2u w; w.x = pk2(v[j].x, v[j].y); w.y = pk2(v[j].z, v[j].w); __builtin_nontemporal_store(w, (v2u*)(xout_b + (size_t)r * DM + 4 * lane + 256 * j)); }
            } else { float* xo = lat ? xout_lat + (size_t)r * DM : xout_ctx + (size_t)(r - TL) * DM;
#pragma unroll
                for (int j = 0; j < 4; ++j) *(f32x4*)(xo + 4 * lane + 256 * j) = v[j]; }
        }
        if (H) {
            float ss = 0.f;
#pragma unroll
            for (int j = 0; j < 4; ++j) ss += v[j].x * v[j].x + v[j].y * v[j].y + v[j].z * v[j].z + v[j].w * v[j].w;
            const float rinv = 1.0f / sqrtf(wave_sum(ss) * (1.0f / DM) + EPSN);
#pragma unroll
            for (int j = 0; j < 4; ++j) { const f32x4 hv = (v[j] * rinv * gpr[j]) * sc[j] + sh[j];
                v2u w; w.x = pk2(hv.x, hv.y); w.y = pk2(hv.z, hv.w); *(v2u*)(H + (size_t)r * DM + 4 * lane + 256 * j) = w; }
        }
    }
}

DI void attn_item(const bf16* P, bf16* MIXO, const float* sinkp, const float* g_att, unsigned char* lds, int qrow0, int qpos0, int brow_lat, int brow_ctx, bool is_ctx) {
    const int tid = otid(), lane = tid & 63, w = tid >> 6, g = w >> 2, r = lane & 31, h = lane >> 5;
    constexpr int KVB = 2 * 2 * 64 * 72;
    bf16* KV0 = (bf16*)lds;
    float* ssq = (float*)(lds + 2 * KVB * 2);
    bf16* Ql = (bf16*)(lds + 2 * KVB * 2 + 2048) + w * (64 * 72);
    const int bi0 = is_ctx ? 0 : (qpos0 >= 128 ? 0 : (qpos0 >= 64 ? 1 : 2));
    const int bi1 = is_ctx ? -1 : min(4, (SEQ + 127 - qpos0) >> 6);
    const int nband = is_ctx ? 0 : bi1 - bi0 + 1, ntiles = nband + 4;
    const int spair = tid & 31, sg = tid >> 8, spart = (tid >> 5) & 7;
    v4u pk[2], pv[2];
#define ATT_TILE_ROW(t) ((t) < nband ? brow_lat + qpos0 - 128 + 64 * (bi0 + (t)) : brow_ctx + 64 * ((t) - nband))
#define ATT_LOAD(t) do { const bf16* src_ = P + (size_t)(ATT_TILE_ROW(t) + 2 * spair) * DIN + 64 * sg + 8 * spart; \
        pk[0] = *(const v4u*)(src_ + C_AK); pk[1] = *(const v4u*)(src_ + DIN + C_AK); pv[0] = *(const v4u*)(src_ + C_AV); pv[1] = *(const v4u*)(src_ + DIN + C_AV); } while (0)
#define ATT_STORE(buf) do { bf16* Kd_ = KV0 + (buf) * KVB; bf16* Vd_ = Kd_ + 2 * 64 * 72; \
        *(v4u*)(Kd_ + (sg * 64 + 2 * spair) * 72 + 8 * spart) = pk[0]; *(v4u*)(Kd_ + (sg * 64 + 2 * spair + 1) * 72 + 8 * spart) = pk[1]; \
        unsigned* vd = (unsigned*)(Vd_ + (sg * 64 + 8 * spart) * 72 + 2 * spair); const v4u a_ = pv[0], b_ = pv[1]; \
        vd[0 * 36] = (a_.x & 0xffffu) | (b_.x << 16); vd[1 * 36] = (a_.x >> 16) | (b_.x & 0xffff0000u); \
        vd[2 * 36] = (a_.y & 0xffffu) | (b_.y << 16); vd[3 * 36] = (a_.y >> 16) | (b_.y & 0xffff0000u); \
        vd[4 * 36] = (a_.z & 0xffffu) | (b_.z << 16); vd[5 * 36] = (a_.z >> 16) | (b_.z & 0xffff0000u); \
        vd[6 * 36] = (a_.w & 0xffffu) | (b_.w << 16); vd[7 * 36] = (a_.w >> 16) | (b_.w & 0xffff0000u); } while (0)
    ATT_LOAD(0);
#pragma unroll
    for (int i = 0; i < 8; ++i) { const int c = lane + 64 * i, row = c >> 3, part = c & 7;
        *(v4u*)(Ql + row * 72 + 8 * part) = *(const v4u*)(P + (size_t)(qrow0 + row) * DIN + C_AQ + 64 * w + 8 * part); }
    f32x16 O[2][2];
#pragma unroll
    for (int qb = 0; qb < 2; ++qb)
#pragma unroll
        for (int db = 0; db < 2; ++db)
#pragma unroll
            for (int i = 0; i < 16; ++i) O[qb][db][i] = 0.f;
    const float sk = sinkp[w] * LOG2E;
    float mrun[2] = {sk, sk}, lrun[2] = {h == 0 ? 1.f : 0.f, h == 0 ? 1.f : 0.f};
    __syncthreads();
    ATT_STORE(0);
#pragma unroll 1
    for (int t = 0; t < ntiles; ++t) {
        const bool band = t < nband; const int bi = bi0 + t;
        const int kpos0 = qpos0 - 128 + 64 * bi; const bool need_mask = band && (bi == 0 || bi == 4);
        if (t + 1 < ntiles) ATT_LOAD(t + 1);
        __syncthreads();
        const bf16* Kl = KV0 + (t & 1) * KVB; const bf16* Vl = Kl + 2 * 64 * 72;
        bf16x8 Kf[2][4], Pf[2][2][2];
#pragma unroll
        for (int kb = 0; kb < 2; ++kb)
#pragma unroll
            for (int s = 0; s < 4; ++s) Kf[kb][s] = *(const bf16x8*)(Kl + (g * 64 + 32 * kb + r) * 72 + 16 * s + 8 * h);
#pragma unroll
        for (int qb = 0; qb < 2; ++qb) {
            f32x16 S[2];
#pragma unroll
            for (int kb = 0; kb < 2; ++kb)
#pragma unroll
                for (int i = 0; i < 16; ++i) S[kb][i] = 0.f;
#pragma unroll
            for (int s = 0; s < 4; ++s) { const bf16x8 qf = *(const bf16x8*)(Ql + (32 * qb + r) * 72 + 16 * s + 8 * h);
                S[0] = MFMA32(Kf[0][s], qf, S[0]); S[1] = MFMA32(Kf[1][s], qf, S[1]); }
            if (need_mask) { const int qp = qpos0 + 32 * qb + r;
#pragma unroll
                for (int kb = 0; kb < 2; ++kb)
#pragma unroll
                    for (int i = 0; i < 16; ++i) { const int kp = kpos0 + 32 * kb + (i & 3) + 8 * (i >> 2) + 4 * h; const int d = kp - qp; if (d > 128 || d < -128) S[kb][i] = -1e30f; } }
            float mx = fmaxf(S[0][0], S[1][0]);
#pragma unroll
            for (int i = 1; i < 16; ++i) mx = fmaxf(mx, fmaxf(S[0][i], S[1][i]));
            mx = fmaxf(mx, __shfl_xor(mx, 32));
            const float mnew = fmaxf(mrun[qb], mx);
            float ps = 0.f;
#pragma unroll
            for (int kb = 0; kb < 2; ++kb)
#pragma unroll
                for (int i = 0; i < 16; ++i) { S[kb][i] = __builtin_amdgcn_exp2f(S[kb][i] - mnew); ps += S[kb][i]; }
            if (__builtin_amdgcn_ballot_w64(mnew > mrun[qb]) != 0ull) {
                const float alpha = __builtin_amdgcn_exp2f(mrun[qb] - mnew);
                lrun[qb] *= alpha;
#pragma unroll
                for (int db = 0; db < 2; ++db)
#pragma unroll
                    for (int i = 0; i < 16; ++i) O[qb][db][i] *= alpha;
            }
            lrun[qb] += ps; mrun[qb] = mnew;
#pragma unroll
            for (int kb = 0; kb < 2; ++kb)
#pragma unroll
                for (int u = 0; u < 2; ++u) { v4u pw; pw.x = pk2(S[kb][8 * u + 0], S[kb][8 * u + 1]); pw.y = pk2(S[kb][8 * u + 2], S[kb][8 * u + 3]); pw.z = pk2(S[kb][8 * u + 4], S[kb][8 * u + 5]); pw.w = pk2(S[kb][8 * u + 6], S[kb][8 * u + 7]);
                    Pf[qb][kb][u] = __builtin_bit_cast(bf16x8, pw); }
        }
#pragma unroll
        for (int kb = 0; kb < 2; ++kb) {
            bf16x8 Vf[2][2];
#pragma unroll
            for (int db = 0; db < 2; ++db)
#pragma unroll
                for (int u = 0; u < 2; ++u) { const bf16* vp = Vl + (g * 64 + 32 * db + r) * 72 + 32 * kb + 16 * u + 4 * h;
                    const s16x4 lo = *(const s16x4*)vp, hi = *(const s16x4*)(vp + 8);
                    Vf[db][u] = __builtin_shufflevector(lo, hi, 0, 1, 2, 3, 4, 5, 6, 7); }
#pragma unroll
            for (int qb = 0; qb < 2; ++qb)
#pragma unroll
                for (int db = 0; db < 2; ++db)
#pragma unroll
                    for (int u = 0; u < 2; ++u) O[qb][db] = MFMA32(Vf[db][u], Pf[qb][kb][u], O[qb][db]);
        }
        if (t + 1 < ntiles) ATT_STORE((t + 1) & 1);
    }
#undef ATT_TILE_ROW
#undef ATT_LOAD
#undef ATT_STORE
#pragma unroll
    for (int qb = 0; qb < 2; ++qb) {
        const float lt = lrun[qb] + __shfl_xor(lrun[qb], 32); const float inv = 1.0f / lt; float ss = 0.f;
#pragma unroll
        for (int db = 0; db < 2; ++db)
#pragma unroll
            for (int i = 0; i < 16; ++i) { O[qb][db][i] *= inv; ss += O[qb][db][i] * O[qb][db][i]; }
        ss += __shfl_xor(ss, 32);
        if (h == 0) ssq[w * 64 + 32 * qb + r] = ss;
    }
    __syncthreads();
#pragma unroll
    for (int qb = 0; qb < 2; ++qb) {
        float tot = 0.f;
#pragma unroll
        for (int w8 = 0; w8 < 8; ++w8) tot += ssq[w8 * 64 + 32 * qb + r];
        const float rinv = 1.0f / sqrtf(tot * (1.0f / 512.0f) + EPSN);
        bf16* orow = MIXO + (size_t)(qrow0 + 32 * qb + r) * DM + 512 + 64 * w;
#pragma unroll
        for (int db = 0; db < 2; ++db)
#pragma unroll
            for (int i4 = 0; i4 < 4; ++i4) { const int d = 32 * db + 8 * i4 + 4 * h; const f32x4 gg = *(const f32x4*)(g_att + 64 * w + d);
                v2u o; o.x = pk2(O[qb][db][4 * i4 + 0] * rinv * gg.x, O[qb][db][4 * i4 + 1] * rinv * gg.y); o.y = pk2(O[qb][db][4 * i4 + 2] * rinv * gg.z, O[qb][db][4 * i4 + 3] * rinv * gg.w);
                *(v2u*)(orow + d) = o; }
    }
    __syncthreads();
}

DI float ldhy(const bf16* P, int rowbase, int t, int LQ, int col) { return (t >= 0 && t < LQ) ? bf2f(P[(size_t)(rowbase + t) * DIN + C_HY + col]) : 0.f; }

DI v4u ldrow8(const bf16* P, int rowbase, int t, int LQ, int col) { v4u z = {0u, 0u, 0u, 0u}; return (t >= 0 && t < LQ) ? *(const v4u*)(P + (size_t)(rowbase + t) * DIN + C_HY + col) : z; }
DI float bfsel(const v4u& q, int k) { const unsigned w = (k >> 1) == 0 ? q.x : ((k >> 1) == 1 ? q.y : ((k >> 1) == 2 ? q.z : q.w)); return (k & 1) ? bfhi(w) : bflo(w); }
DI void hypre_item(const bf16* P, const float* sw, const float* sbias, bf16* Zt, unsigned char* lds, int rowbase, int b, int t0, int LQ) {
    const int tid = otid(); bf16* zl = (bf16*)lds;
    { const size_t oz = ozero(); sw += oz; sbias += oz; }
    const int lane = tid & 63, ts = lane & 15, cg = (tid >> 6) * 4 + (lane >> 4), c0 = 8 * cg, tb = t0 + 4 * ts;
    __syncthreads();
    v4u rv[6], rx[6];
#pragma unroll
    for (int i = 0; i < 6; ++i) { rv[i] = ldrow8(P, rowbase, tb - 1 + i, LQ, c0); rx[i] = ldrow8(P, rowbase, tb - 1 + i, LQ, 256 + c0); }
#pragma unroll
    for (int k = 0; k < 8; ++k) {
        const float w0v = sw[c0 + k], w1v = sw[768 + c0 + k], w2v = sw[1536 + c0 + k], bv = sbias[c0 + k];
        const float w0x = sw[256 + c0 + k], w1x = sw[768 + 256 + c0 + k], w2x = sw[1536 + 256 + c0 + k], bx = sbias[256 + c0 + k];
        float z[4];
#pragma unroll
        for (int tt = 0; tt < 4; ++tt) { const float uv = w0v * bfsel(rv[tt], k) + w1v * bfsel(rv[tt + 1], k) + w2v * bfsel(rv[tt + 2], k) + bv;
            const float ux = w0x * bfsel(rx[tt], k) + w1x * bfsel(rx[tt + 1], k) + w2x * bfsel(rx[tt + 2], k) + bx; z[tt] = uv * ux; }
        v2u o; o.x = pk2(z[0], z[1]); o.y = pk2(z[2], z[3]);
        *(v2u*)(zl + (c0 + k) * 72 + 4 * ts) = o; }
    __syncthreads();
    { const int c2 = tid >> 1, hh = tid & 1;
#pragma unroll
      for (int i = 0; i < 4; ++i) *(v4u*)(Zt + ((size_t)c2 * 32 + b) * LQ + t0 + 32 * hh + 8 * i) = *(const v4u*)(zl + c2 * 72 + 32 * hh + 8 * i); }
}

template <int LQ> DI void hyconv_item(const bf16* Ztc, const bf16* R, bf16* Ytc, unsigned char* lds) {
    constexpr int ZS = LQ + 8;
    const int tid = otid(), lane = tid & 63, wave = tid >> 6, r = lane & 31, h = lane >> 5;
    bf16* Zl = (bf16*)lds; bf16* R0 = Zl + 32 * ZS; bf16* R1 = R0 + 2 * LQ;
    __syncthreads();
    for (int c = tid; c < 32 * LQ / 8; c += 512) { const int b = c / (LQ / 8), part = c % (LQ / 8); *(v4u*)(Zl + b * ZS + 8 * part) = *(const v4u*)(Ztc + (size_t)b * LQ + 8 * part); }
    for (int x = tid; x < 2 * LQ; x += 512) { R0[x] = R[x]; R1[x] = (x + 1 < 2 * LQ) ? R[x + 1] : (bf16)0; }
    __syncthreads();
    constexpr int TPW = LQ / 8 / 32;
    const int tw = wave * (LQ / 8);
    f32x16 acc[TPW];
#pragma unroll
    for (int k = 0; k < TPW; ++k)
#pragma unroll
        for (int i = 0; i < 16; ++i) acc[k][i] = 0.f;
    const bf16* abase = (r & 1) ? (R0 + (LQ - 1) - r + 8 * h) : (R1 + (LQ - 2) - r + 8 * h);
    const bf16* bbase = Zl + r * ZS + 8 * h;
    const int dmid0 = tw + 32 * (TPW - 1) - (LQ - 16), dmid1 = tw;
#pragma unroll 1
    for (int d = tw - (LQ - 16); d <= tw + 32 * (TPW - 1); d += 16) {
        if (d == dmid0) {
#pragma unroll 1
            for (; d <= dmid1; d += 16) {
                const unsigned* ap = (const unsigned*)(abase - d);
                v4u av; av.x = ap[0]; av.y = ap[1]; av.z = ap[2]; av.w = ap[3];
                const bf16x8 A = __builtin_bit_cast(bf16x8, av);
                bf16x8 Bv[TPW];
#pragma unroll
                for (int k = 0; k < TPW; ++k) Bv[k] = *(const bf16x8*)(bbase + (tw + 32 * k - d));
#pragma unroll
                for (int k = 0; k < TPW; ++k) acc[k] = MFMA32(A, Bv[k], acc[k]);
            }
            if (d > tw + 32 * (TPW - 1)) break;
        }
        const unsigned* ap = (const unsigned*)(abase - d);
        v4u av; av.x = ap[0]; av.y = ap[1]; av.z = ap[2]; av.w = ap[3];
        const bf16x8 A = __builtin_bit_cast(bf16x8, av);
#pragma unroll
        for (int k = 0; k < TPW; ++k) { const int s0 = tw + 32 * k - d;
            if (s0 >= 0 && s0 < LQ) { const bf16x8 B = *(const bf16x8*)(bbase + s0); acc[k] = MFMA32(A, B, acc[k]); } }
    }
#pragma unroll
    for (int k = 0; k < TPW; ++k)
#pragma unroll
        for (int i4 = 0; i4 < 4; ++i4) { const int t = tw + 32 * k + 8 * i4 + 4 * h;
            v2u o; o.x = pk2(acc[k][4 * i4 + 0], acc[k][4 * i4 + 1]); o.y = pk2(acc[k][4 * i4 + 2], acc[k][4 * i4 + 3]);
            *(v2u*)(Ytc + (size_t)r * LQ + t) = o; }
}

DI void hypost_item(const bf16* P, const float* sw, const float* sbias, const float* hbias, const float* g_hy, const bf16* Yt, bf16* MIXO, unsigned char* lds, int rowbase, int b, int t0, int LQ) {
    const int tid = otid(), lane = tid & 63, wave = tid >> 6;
    bf16* yl = (bf16*)lds; float* ol = (float*)(lds + 256 * 72 * 2);
    { const size_t oz = ozero(); sw += oz; sbias += oz; hbias += oz; g_hy += oz; }
    const int ts = lane & 15, cg = wave * 4 + (lane >> 4), c0 = 8 * cg, tb = t0 + 4 * ts;
    __syncthreads();
    { const int c2 = tid >> 1, hh = tid & 1;
#pragma unroll
      for (int i = 0; i < 4; ++i) *(v4u*)(yl + c2 * 72 + 32 * hh + 8 * i) = *(const v4u*)(Yt + ((size_t)c2 * 32 + b) * LQ + t0 + 32 * hh + 8 * i); }
    v4u rv[6], rx[6], ro[6];
#pragma unroll
    for (int i = 0; i < 6; ++i) { rv[i] = ldrow8(P, rowbase, tb - 1 + i, LQ, c0); rx[i] = ldrow8(P, rowbase, tb - 1 + i, LQ, 256 + c0); ro[i] = ldrow8(P, rowbase, tb - 1 + i, LQ, 512 + c0); }
    __syncthreads();
    float res[4][8];
#pragma unroll
    for (int k = 0; k < 8; ++k) {
        const float w0v = sw[c0 + k], w1v = sw[768 + c0 + k], w2v = sw[1536 + c0 + k], bv = sbias[c0 + k];
        const float w0x = sw[256 + c0 + k], w1x = sw[768 + 256 + c0 + k], w2x = sw[1536 + 256 + c0 + k], bx = sbias[256 + c0 + k];
        const float w0o = sw[512 + c0 + k], w1o = sw[768 + 512 + c0 + k], w2o = sw[1536 + 512 + c0 + k], bo = sbias[512 + c0 + k];
        const float hb = hbias[c0 + k];
        const v2u yq = *(const v2u*)(yl + (c0 + k) * 72 + 4 * ts);
        const float yv[4] = {bflo(yq.x), bfhi(yq.x), bflo(yq.y), bfhi(yq.y)};
#pragma unroll
        for (int tt = 0; tt < 4; ++tt) { const float uv = w0v * bfsel(rv[tt], k) + w1v * bfsel(rv[tt + 1], k) + w2v * bfsel(rv[tt + 2], k) + bv;
            const float ux = w0x * bfsel(rx[tt], k) + w1x * bfsel(rx[tt + 1], k) + w2x * bfsel(rx[tt + 2], k) + bx;
            const float uo = w0o * bfsel(ro[tt], k) + w1o * bfsel(ro[tt + 1], k) + w2o * bfsel(ro[tt + 2], k) + bo;
            res[tt][k] = (yv[tt] + uv * ux * hb) * uo; } }
#pragma unroll
    for (int tt = 0; tt < 4; ++tt) { float* od = ol + (4 * ts + tt) * 260 + c0;
        *(f32x4*)od = (f32x4){res[tt][0], res[tt][1], res[tt][2], res[tt][3]}; *(f32x4*)(od + 4) = (f32x4){res[tt][4], res[tt][5], res[tt][6], res[tt][7]}; }
    __syncthreads();
    { const int tt = 8 * wave + (lane >> 3), sub = lane & 7;
      f32x4 v[8]; float ss = 0.f;
#pragma unroll
      for (int q = 0; q < 8; ++q) { v[q] = *(const f32x4*)(ol + tt * 260 + 4 * sub + 32 * q); ss += v[q].x * v[q].x + v[q].y * v[q].y + v[q].z * v[q].z + v[q].w * v[q].w; }
      ss += dpp_mov<0xB1>(ss); ss += dpp_mov<0x4E>(ss); ss += dpp_mov<0x141>(ss);
      const float rinv = 1.0f / sqrtf(ss * (1.0f / 256.0f) + EPSN);
      bf16* orow = MIXO + (size_t)(rowbase + t0 + tt) * DM + 256 + 4 * sub;
#pragma unroll
      for (int q = 0; q < 8; ++q) { const f32x4 gg = *(const f32x4*)(g_hy + 4 * sub + 32 * q);
          v2u o; o.x = pk2(v[q].x * rinv * gg.x, v[q].y * rinv * gg.y); o.y = pk2(v[q].z * rinv * gg.z, v[q].w * rinv * gg.w);
          *(v2u*)(orow + 32 * q) = o; } }
}

DI int ret_rowbase(int b, int np) { return np < 2 ? TL + b * LC + 128 * np : b * SEQ + 128 * (np - 2); }
DI float ret_l2g(const float* dec, int h) { return log1pf(-expf(dec[h])) * LOG2E; }

DI void ret_stage_vt(const bf16* P, int rowbase, bf16* VT, int tid) {
#pragma unroll 2
    for (int i = 0; i < 4; ++i) { const int c = tid + 512 * i, part = c >> 6, jp = c & 63;
        const bf16* src = P + (size_t)(rowbase + 2 * jp) * DIN + C_RV + 8 * part;
        const v4u a_ = *(const v4u*)src, b_ = *(const v4u*)(src + DIN);
        unsigned* vd = (unsigned*)(VT + (8 * part) * 136 + 2 * jp);
        vd[0 * 68] = (a_.x & 0xffffu) | (b_.x << 16); vd[1 * 68] = (a_.x >> 16) | (b_.x & 0xffff0000u);
        vd[2 * 68] = (a_.y & 0xffffu) | (b_.y << 16); vd[3 * 68] = (a_.y >> 16) | (b_.y & 0xffff0000u);
        vd[4 * 68] = (a_.z & 0xffffu) | (b_.z << 16); vd[5 * 68] = (a_.z >> 16) | (b_.z & 0xffff0000u);
        vd[6 * 68] = (a_.w & 0xffffu) | (b_.w << 16); vd[7 * 68] = (a_.w >> 16) | (b_.w & 0xffff0000u); }
}

DI void retkv_mfma_item(const bf16* P, float* KV, const float* dec_f, const float* dec_b, unsigned char* lds, int b, int np) {
    const int tid = otid(), lane = tid & 63, w = tid >> 6, r = lane & 31, hh = lane >> 5;
    bf16* VT = (bf16*)lds; bf16* KFT = VT + 4 * 64 * 136; bf16* KBT = KFT + 4 * 32 * 136;
    const int rowbase = ret_rowbase(b, np);
    __syncthreads();
    ret_stage_vt(P, rowbase, VT, tid);
#pragma unroll 1
    for (int i = 0; i < 2; ++i) { const int c = tid + 512 * i, part = c >> 6, jp = c & 63, h = part >> 2, j = 2 * jp;
        const float l2f = ret_l2g(dec_f, h), l2b = ret_l2g(dec_b, h);
        const float wf0 = exp2f(l2f * (float)(127 - j)), wf1 = exp2f(l2f * (float)(126 - j)), wb0 = exp2f(l2b * (float)j), wb1 = exp2f(l2b * (float)(j + 1));
        const bf16* src = P + (size_t)(rowbase + j) * DIN + C_RK + 8 * part;
        const v4u a_ = *(const v4u*)src, b_ = *(const v4u*)(src + DIN);
        const float ka[8] = {bflo(a_.x), bfhi(a_.x), bflo(a_.y), bfhi(a_.y), bflo(a_.z), bfhi(a_.z), bflo(a_.w), bfhi(a_.w)};
        const float kb[8] = {bflo(b_.x), bfhi(b_.x), bflo(b_.y), bfhi(b_.y), bflo(b_.z), bfhi(b_.z), bflo(b_.w), bfhi(b_.w)};
        unsigned* fd = (unsigned*)(KFT + (8 * part) * 136 + j); unsigned* bd = (unsigned*)(KBT + (8 * part) * 136 + j);
#pragma unroll
        for (int jj = 0; jj < 8; ++jj) { fd[jj * 68] = pk2(ka[jj] * wf0, kb[jj] * wf1); bd[jj * 68] = pk2(ka[jj] * wb0, kb[jj] * wb1); } }
    __syncthreads();
    const int h = w & 3, dir = w >> 2;
    const bf16* KT = (dir ? KBT : KFT) + (h * 32 + r) * 136 + 8 * hh;
    const bf16* VB = VT + (h * 64 + r) * 136 + 8 * hh;
    f32x16 C[2];
#pragma unroll
    for (int eb = 0; eb < 2; ++eb)
#pragma unroll
        for (int i = 0; i < 16; ++i) C[eb][i] = 0.f;
#pragma unroll
    for (int ks = 0; ks < 8; ++ks) { const bf16x8 A = *(const bf16x8*)(KT + 16 * ks);
#pragma unroll
        for (int eb = 0; eb < 2; ++eb) { const bf16x8 B = *(const bf16x8*)(VB + (32 * eb) * 136 + 16 * ks); C[eb] = MFMA32(A, B, C[eb]); } }
    float* o = KV + (size_t)dir * NB * NCH * 4 * 2048 + ((size_t)(b * NCH + np) * 4 + h) * 2048 + r;
#pragma unroll
    for (int eb = 0; eb < 2; ++eb)
#pragma unroll
        for (int i = 0; i < 16; ++i) o[((i & 3) + 8 * (i >> 2) + 4 * hh) * 64 + 32 * eb] = C[eb][i];
}

DI void ret_scan_task(float* KV, const float* dec_f, const float* dec_b, int t, int lane) {
    const int b = t >> 6, rem = t & 63, h = rem >> 4, dir = (rem >> 3) & 1, dq = rem & 7;
    const float cdec = exp2f(ret_l2g(dir ? dec_b : dec_f, h) * 128.f);
    const size_t base = (size_t)dir * NB * NCH * 4 * 2048 + ((size_t)(b * NCH) * 4 + h) * 2048 + (size_t)(4 * dq) * 64 + lane;
    const float* src = KV + base; float* dst = KV + (size_t)2 * NB * NCH * 4 * 2048 + base;
    float v[18][4];
#pragma unroll
    for (int k = 0; k < 18; ++k) { const int m = dir ? (k == 0 ? 1 : (k == 1 ? 0 : 19 - k)) : k;
#pragma unroll
        for (int dd = 0; dd < 4; ++dd) v[k][dd] = src[(size_t)m * 4 * 2048 + dd * 64]; }
    float sst[4] = {0.f, 0.f, 0.f, 0.f};
#pragma unroll
    for (int k = 0; k < 18; ++k) { const int m = dir ? (k == 0 ? 1 : (k == 1 ? 0 : 19 - k)) : k;
#pragma unroll
        for (int dd = 0; dd < 4; ++dd) { dst[(size_t)m * 4 * 2048 + dd * 64] = sst[dd]; sst[dd] = cdec * sst[dd] + v[k][dd]; } }
}

DI void retout_mfma_item(const bf16* P, const float* KV, bf16* MIXO, const float* dec_f, const float* dec_b, const float* g_ret, unsigned char* lds, int b, int np) {
    const int tid = otid(), lane = tid & 63, w = tid >> 6, r = lane & 31, hh = lane >> 5;
    bf16* VT = (bf16*)lds; bf16* STT = VT + 4 * 64 * 136; float* ssq = (float*)(STT + 8 * 64 * 40);
    const int rowbase = ret_rowbase(b, np);
    __syncthreads();
    ret_stage_vt(P, rowbase, VT, tid);
    {
        const int h = w & 3, dir = w >> 2;
        float sreg[32];
        const float* src = KV + (size_t)(2 + dir) * NB * NCH * 4 * 2048 + ((size_t)(b * NCH + np) * 4 + h) * 2048 + lane;
#pragma unroll
        for (int d = 0; d < 32; ++d) sreg[d] = src[d * 64];
        bf16* sd = STT + (w * 64 + lane) * 40;
#pragma unroll
        for (int d4 = 0; d4 < 4; ++d4) { v4u o; o.x = pk2(sreg[8 * d4], sreg[8 * d4 + 1]); o.y = pk2(sreg[8 * d4 + 2], sreg[8 * d4 + 3]); o.z = pk2(sreg[8 * d4 + 4], sreg[8 * d4 + 5]); o.w = pk2(sreg[8 * d4 + 6], sreg[8 * d4 + 7]);
            *(v4u*)(sd + 8 * d4) = o; }
    }
    __syncthreads();
    const int h = w & 3, qh = w >> 2;
    const float l2f = ret_l2g(dec_f, h), l2b = ret_l2g(dec_b, h);
    bf16x8 Qf[2][2];
#pragma unroll
    for (int qb = 0; qb < 2; ++qb)
#pragma unroll
        for (int s = 0; s < 2; ++s) Qf[qb][s] = *(const bf16x8*)(P + (size_t)(rowbase + 64 * qh + 32 * qb + r) * DIN + C_RQ + 32 * h + 16 * s + 8 * hh);
    float cf1[4], cf8[4], cb1[4], cb8[4];
#pragma unroll
    for (int i = 0; i < 4; ++i) { cf1[i] = exp2f(-l2f * (float)i); cf8[i] = exp2f(-l2f * (float)(8 * i + 4 * hh)); cb1[i] = exp2f(l2b * (float)i); cb8[i] = exp2f(l2b * (float)(8 * i + 4 * hh)); }
    f32x16 O[2][2];
#pragma unroll
    for (int qb = 0; qb < 2; ++qb)
#pragma unroll
        for (int eb = 0; eb < 2; ++eb)
#pragma unroll
            for (int i = 0; i < 16; ++i) O[qb][eb][i] = 0.f;
#pragma unroll 1
    for (int jb = 0; jb < 4; ++jb) {
        bf16x8 Kf[2];
#pragma unroll
        for (int s = 0; s < 2; ++s) Kf[s] = *(const bf16x8*)(P + (size_t)(rowbase + 32 * jb + r) * DIN + C_RK + 32 * h + 16 * s + 8 * hh);
        bf16x8 Vf[2][2];
#pragma unroll
        for (int eb = 0; eb < 2; ++eb)
#pragma unroll
            for (int u = 0; u < 2; ++u) { const bf16* vp = VT + (h * 64 + 32 * eb + r) * 136 + 32 * jb + 16 * u + 4 * hh;
                const s16x4 lo = *(const s16x4*)vp, hi = *(const s16x4*)(vp + 8); Vf[eb][u] = __builtin_shufflevector(lo, hi, 0, 1, 2, 3, 4, 5, 6, 7); }
#pragma unroll
        for (int qb = 0; qb < 2; ++qb) {
            f32x16 S;
#pragma unroll
            for (int i = 0; i < 16; ++i) S[i] = 0.f;
#pragma unroll
            for (int s = 0; s < 2; ++s) S = MFMA32(Kf[s], Qf[qb][s], S);
            const int qbg = 2 * qh + qb; const float iloc = (float)(32 * qbg + r);
            if (jb < qbg) { const float rf = exp2f(l2f * (iloc - (float)(32 * jb)));
#pragma unroll
                for (int i4 = 0; i4 < 4; ++i4) { const float r8 = rf * cf8[i4];
#pragma unroll
                    for (int i = 0; i < 4; ++i) S[4 * i4 + i] *= r8 * cf1[i]; } }
            else if (jb > qbg) { const float rb = exp2f(l2b * ((float)(32 * jb) - iloc));
#pragma unroll
                for (int i4 = 0; i4 < 4; ++i4) { const float r8 = rb * cb8[i4];
#pragma unroll
                    for (int i = 0; i < 4; ++i) S[4 * i4 + i] *= r8 * cb1[i]; } }
            else {
#pragma unroll
                for (int i = 0; i < 16; ++i) { const int diff = r - ((i & 3) + 8 * (i >> 2) + 4 * hh); float wgt = 0.f;
                    if (diff >= 0) wgt += exp2f(l2f * (float)diff);
                    if (diff <= 0) wgt += exp2f(-l2b * (float)diff);
                    S[i] *= wgt; } }
            bf16x8 Pf[2];
#pragma unroll
            for (int u = 0; u < 2; ++u) { v4u pw; pw.x = pk2(S[8 * u + 0], S[8 * u + 1]); pw.y = pk2(S[8 * u + 2], S[8 * u + 3]); pw.z = pk2(S[8 * u + 4], S[8 * u + 5]); pw.w = pk2(S[8 * u + 6], S[8 * u + 7]);
                Pf[u] = __builtin_bit_cast(bf16x8, pw); }
#pragma unroll
            for (int eb = 0; eb < 2; ++eb)
#pragma unroll
                for (int u = 0; u < 2; ++u) O[qb][eb] = MFMA32(Vf[eb][u], Pf[u], O[qb][eb]);
        }
    }
#pragma unroll
    for (int dir = 0; dir < 2; ++dir)
#pragma unroll
        for (int eb = 0; eb < 2; ++eb) {
            bf16x8 Sf[2];
#pragma unroll
            for (int s = 0; s < 2; ++s) Sf[s] = *(const bf16x8*)(STT + ((dir * 4 + h) * 64 + 32 * eb + r) * 40 + 16 * s + 8 * hh);
#pragma unroll
            for (int qb = 0; qb < 2; ++qb) { f32x16 X;
#pragma unroll
                for (int i = 0; i < 16; ++i) X[i] = 0.f;
#pragma unroll
                for (int s = 0; s < 2; ++s) X = MFMA32(Sf[s], Qf[qb][s], X);
                const float iloc = (float)(64 * qh + 32 * qb + r);
                const float fac = dir ? exp2f(l2b * (128.f - iloc)) : exp2f(l2f * (iloc + 1.f));
#pragma unroll
                for (int i = 0; i < 16; ++i) O[qb][eb][i] += fac * X[i]; }
        }
#pragma unroll
    for (int qb = 0; qb < 2; ++qb) {
        float ss = 0.f;
#pragma unroll
        for (int eb = 0; eb < 2; ++eb)
#pragma unroll
            for (int i = 0; i < 16; ++i) ss += O[qb][eb][i] * O[qb][eb][i];
        ss += __shfl_xor(ss, 32);
        const float rinv = 1.0f / sqrtf(ss * (1.0f / 64.0f) + EPSN);
        const bf16* grow = P + (size_t)(rowbase + 64 * qh + 32 * qb + r) * DIN + C_RG + 64 * h;
        float s2 = 0.f;
#pragma unroll
        for (int eb = 0; eb < 2; ++eb)
#pragma unroll
            for (int i4 = 0; i4 < 4; ++i4) { const v2u gq = *(const v2u*)(grow + 32 * eb + 8 * i4 + 4 * hh);
                const float g0 = bflo(gq.x), g1 = bfhi(gq.x), g2 = bflo(gq.y), g3 = bfhi(gq.y);
                O[qb][eb][4 * i4 + 0] *= rinv * g0; O[qb][eb][4 * i4 + 1] *= rinv * g1; O[qb][eb][4 * i4 + 2] *= rinv * g2; O[qb][eb][4 * i4 + 3] *= rinv * g3;
                s2 += O[qb][eb][4 * i4 + 0] * O[qb][eb][4 * i4 + 0] + O[qb][eb][4 * i4 + 1] * O[qb][eb][4 * i4 + 1] + O[qb][eb][4 * i4 + 2] * O[qb][eb][4 * i4 + 2] + O[qb][eb][4 * i4 + 3] * O[qb][eb][4 * i4 + 3]; }
        s2 += __shfl_xor(s2, 32);
        if (hh == 0) ssq[h * 128 + 64 * qh + 32 * qb + r] = s2;
    }
    __syncthreads();
#pragma unroll
    for (int qb = 0; qb < 2; ++qb) { const int il = 64 * qh + 32 * qb + r;
        const float tot = ssq[il] + ssq[128 + il] + ssq[256 + il] + ssq[384 + il];
        const float rinv = 1.0f / sqrtf(tot * (1.0f / 256.0f) + EPSN);
        bf16* orow = MIXO + (size_t)(rowbase + il) * DM + 64 * h;
#pragma unroll
        for (int eb = 0; eb < 2; ++eb)
#pragma unroll
            for (int i4 = 0; i4 < 4; ++i4) { const int e = 32 * eb + 8 * i4 + 4 * hh; const f32x4 gg = *(const f32x4*)(g_ret + 64 * h + e);
                v2u o; o.x = pk2(O[qb][eb][4 * i4 + 0] * rinv * gg.x, O[qb][eb][4 * i4 + 1] * rinv * gg.y); o.y = pk2(O[qb][eb][4 * i4 + 2] * rinv * gg.z, O[qb][eb][4 * i4 + 3] * rinv * gg.w);
                *(v2u*)(orow + e) = o; }
    }
}

#define LAS __attribute__((address_space(3)))
#define XB_TMO      128
#define XB_XCNT(j)  (256  + 64 * (j))
#define XB_XSUB(j)  (1280 + 64 * (j))
#define XB_XGEN(j)  (2304 + 64 * (j))
#define XB_TOP      3328
#define XB_TOPGEN   3392
#define XCD_BAR_WORDS 3456
#define XB_SPIN_CAP (1u << 18)

__device__ __forceinline__ unsigned xb_ld(unsigned* p)              { return __hip_atomic_load(p, __ATOMIC_RELAXED, __HIP_MEMORY_SCOPE_AGENT); }
__device__ __forceinline__ unsigned xb_add(unsigned* p, unsigned v) { return __hip_atomic_fetch_add(p, v, __ATOMIC_RELAXED, __HIP_MEMORY_SCOPE_AGENT); }
__device__ __forceinline__ unsigned xb_xcc_id() { return (unsigned)__builtin_amdgcn_s_getreg((3 << 11) | 20) & 0xFu; }
#define XB_SPIN(cond, bar) do { unsigned _sp = 0; while (cond) { __builtin_amdgcn_s_sleep(1); \
    if ((++_sp & 255u) == 0u) { if (xb_ld(&(bar)[XB_TMO])) break; if (_sp > XB_SPIN_CAP) { atomicAdd(&(bar)[XB_TMO], 1u); break; } } } } while (0)

struct XcdBarrier {
    unsigned* bar; unsigned x;
    volatile LAS unsigned* st;
};

__device__ __forceinline__ XcdBarrier xcd_barrier_post(unsigned* bar, volatile LAS unsigned* st) {
    XcdBarrier b; b.bar = bar; b.x = xb_xcc_id(); b.st = st;
    if (threadIdx.x == 0) (void)xb_add(&bar[XB_XCNT(b.x)], 1u);
    return b;
}
__device__ __forceinline__ void xcd_barrier_complete(unsigned* bar, unsigned x, unsigned& nloc, unsigned& nx) {
    const unsigned G = gridDim.x * gridDim.y * gridDim.z;
    unsigned sum, cnt, mine, sp = 0u;
    for (;;) {
        sum = 0u; cnt = 0u; mine = 0u;
#pragma unroll
        for (unsigned j = 0; j < 16; ++j) { const unsigned c = xb_ld(&bar[XB_XCNT(j)]); sum += c; cnt += (c > 0u) ? 1u : 0u; mine = (j == x) ? c : mine; }
        if (sum == G) break;
        __builtin_amdgcn_s_sleep(1);
        if ((++sp & 255u) == 0u) { if (xb_ld(&bar[XB_TMO])) break; if (sp > XB_SPIN_CAP) { atomicAdd(&bar[XB_TMO], 1u); break; } }
    }
    nloc = mine > 0u ? mine : 1u; nx = cnt > 0u ? cnt : 1u;
}

__device__ __forceinline__ void xcd_barrier(const XcdBarrier& b) {
    asm volatile("s_waitcnt vmcnt(0)" ::: "memory");
    __syncthreads();
    if (threadIdx.x == 0) {
        unsigned* bar = b.bar; const unsigned bx = xb_xcc_id();
        __builtin_amdgcn_s_waitcnt(0);
        unsigned nloc = b.st[0], nx = b.st[1];
        if (nloc == 0u) { xcd_barrier_complete(bar, bx, nloc, nx); b.st[0] = nloc; b.st[1] = nx; }
        const unsigned old = xb_add(&bar[XB_XSUB(bx)], 1u);
        const unsigned gen = old / nloc;
        if (old + 1u == (gen + 1u) * nloc) {
            __builtin_amdgcn_fence(__ATOMIC_RELEASE, "agent");
            asm volatile("s_waitcnt vmcnt(0)" ::: "memory");
            const unsigned og = xb_add(&bar[XB_TOP], 1u);
            const unsigned tg = og / nx;
            if (og + 1u == (tg + 1u) * nx) xb_add(&bar[XB_TOPGEN], 1u);
            else XB_SPIN(xb_ld(&bar[XB_TOPGEN]) == tg, bar);
            __builtin_amdgcn_fence(__ATOMIC_ACQUIRE, "agent");
            xb_add(&bar[XB_XGEN(bx)], 1u);
            asm volatile("s_waitcnt vmcnt(0)" ::: "memory");
        } else {
            XB_SPIN(xb_ld(&bar[XB_XGEN(bx)]) == gen, bar);
            __builtin_amdgcn_fence(__ATOMIC_ACQUIRE, "agent");
            asm volatile("s_waitcnt vmcnt(0)" ::: "memory");
        }
    }
    __syncthreads();
}


__global__ void __launch_bounds__(512, 2) mega_fwd(Args a) {
    extern __shared__ __attribute__((aligned(16))) unsigned char lds[];
    cg::grid_group grid = cg::this_grid();
    volatile LAS unsigned* xst = (volatile LAS unsigned*)(lds + LDS_BYTES - 16);
    if (threadIdx.x < 2) xst[threadIdx.x] = 0u;
    if (blockIdx.x == 0) { for (int i = threadIdx.x; i < XCD_BAR_WORDS; i += 512) ((unsigned*)a.ws)[i] = 0u; }
    __syncthreads();
#define GSYNC() xcd_barrier(xbar)
    const int bid = blockIdx.x, G = gridDim.x;
    unsigned char* ws = a.ws;
    bf16* const P = (bf16*)(ws + WS_P); bf16* const MIXO = (bf16*)(ws + WS_MIXO); bf16* const YH = (bf16*)(ws + WS_YH); bf16* const U = (bf16*)(ws + WS_U);
    bf16* const XB = (bf16*)(ws + WS_XB); float* const KV = (float*)(ws + WS_KV); const float* const ADA = (const float*)(ws + WS_ADA);
    unsigned char* const ob = (unsigned char*)a.out;
    bf16* const ZT = (bf16*)(ob + OUT_ZT); bf16* const ZTC = (bf16*)(ob + OUT_ZTC); bf16* const YT = (bf16*)(ob + OUT_YT); bf16* const YTC = (bf16*)(ob + OUT_YTC);

    p0_prologue(a, lds, bid, G);
    grid.sync();
    const XcdBarrier xbar = xcd_barrier_post((unsigned*)a.ws, xst);
    ew_phase(a.in[0], a.in[2], nullptr, nullptr, nullptr, nullptr, nullptr, nullptr, 0, nullptr, YH, ADA, 0, 1024, a.in[6], TT, bid, G);
    GSYNC();

#pragma unroll 1
    for (int l = 0; l < DEPTH; ++l) {
        const bool last = (l == DEPTH - 1);
        const unsigned char* wl = ws + WS_W + (size_t)l * W_LAYER;
        const float* ada_l = ADA + (size_t)l * 33 * 6144;
        const int Mo = last ? TL : TT;
        { pg8::Gemm g{(const pg8::bf16_t*)YH, (const pg8::bf16_t*)(wl + WO_IN), TT, DIN, DM}; pg8::StaticOrder S; S.init(TT, DIN, G, bid);
          pg8::EpiWin E{(pg8::bf16_t*)P, (const float*)(ws + WS_ROTR), (const float*)(ws + WS_ROTA)};
          pg8::gemm_phase<pg8::EpiWin, pg8::StaticOrder, true, true>((PG8_LAS unsigned char*)lds, g, S, E); }
        GSYNC();
        {
            const int nA = 1024 + (last ? 0 : 128), nH = 1024 + (last ? 0 : 128), nR = NB * NCH;
            const float* sw = a.in[13] + (size_t)l * 3 * 768; const float* sbias = a.in[14] + l * 768;
            const int vb = (G & 7) == 0 ? (bid & 7) * (G >> 3) + (bid >> 3) : bid;
            for (int it = vb; it < nA + nH + nR; it += G) {
                if (it < nA) {
                    if (it < 1024) { const int b = 31 - (it >> 5), qb = it & 31; attn_item(P, MIXO, a.in[22] + l * 8, a.in[25] + l * 512, lds, b * SEQ + 64 * qb, 64 * qb, b * SEQ, TL + b * LC, false); }
                    else { const int j = it - 1024, b = j >> 2, qb = j & 3; attn_item(P, MIXO, a.in[22] + l * 8, a.in[25] + l * 512, lds, TL + b * LC + 64 * qb, 0, b * SEQ, TL + b * LC, true); }
                } else if (it < nA + nH) {
                    const int j = it - nA;
                    if (j < 1024) { const int b = 31 - (j >> 5), tb = j & 31; hypre_item(P, sw, sbias, ZT, lds, b * SEQ, b, 64 * tb, SEQ); }
                    else { const int jj = j - 1024, b = jj >> 2, tb = jj & 3; hypre_item(P, sw, sbias, ZTC, lds, TL + b * LC, b, 64 * tb, LC); }
                } else {
                    const int j = it - nA - nH; retkv_mfma_item(P, KV, a.in[11] + l * 4, a.in[12] + l * 4, lds, 31 - j / NCH, j % NCH);
                }
            }
        }
        GSYNC();
        {
            {
            { const int tq = otid(); for (int t = bid * 8 + (tq >> 6); t < NB * 64; t += G * 8) ret_scan_task(KV, a.in[11] + l * 4, a.in[12] + l * 4, t, tq & 63); }
            const int nC = 256, nCc = last ? 0 : 256;
            for (int it = bid; it < nC + nCc; it += G) {
                if (it < nC) hyconv_item<SEQ>(ZT + (size_t)it * 32 * SEQ, (const bf16*)(ws + WS_RF) + ((size_t)l * 256 + it) * 4096, YT + (size_t)it * 32 * SEQ, lds);
                else { const int c = it - nC; hyconv_item<LC>(ZTC + (size_t)c * 32 * LC, (const bf16*)(ws + WS_RC) + ((size_t)l * 256 + c) * 512, YTC + (size_t)c * 32 * LC, lds); }
            } }
        }
        GSYNC();
        {
            const int nRo = NB * (last ? 16 : 18), nH = 1024 + (last ? 0 : 128);
            const float* sw = a.in[13] + (size_t)l * 3 * 768; const float* sbias = a.in[14] + l * 768;
            for (int it = bid; it < nRo + nH; it += G) {
                if (it < nRo) { int b, np; if (last) { b = it >> 4; np = 2 + (it & 15); } else { b = it / 18; np = it % 18; }
                    retout_mfma_item(P, KV, MIXO, a.in[11] + l * 4, a.in[12] + l * 4, a.in[23] + l * 256, lds, b, np); }
                else { const int j = it - nRo;
                    if (j < 1024) { const int b = j >> 5, tb = j & 31; hypost_item(P, sw, sbias, a.in[21] + l * 256, a.in[24] + l * 256, YT, MIXO, lds, b * SEQ, b, 64 * tb, SEQ); }
                    else { const int jj = j - 1024, b = jj >> 2, tb = jj & 3; hypost_item(P, sw, sbias, a.in[21] + l * 256, a.in[24] + l * 256, YTC, MIXO, lds, TL + b * LC, b, 64 * tb, LC); } }
            }
        }
        GSYNC();
        { pg8::Gemm g{(const pg8::bf16_t*)MIXO, (const pg8::bf16_t*)(wl + WO_OUT), Mo, DM, DM}; pg8::StaticOrder S; S.init(Mo, DM, G, bid);
          pg8::EpiBf16<0> E{(pg8::bf16_t*)YH, DM};
          pg8::gemm_phase<pg8::EpiBf16<0>, pg8::StaticOrder, true, true>((PG8_LAS unsigned char*)lds, g, S, E); }
        GSYNC();
        ew_phase(a.in[0], a.in[2], l == 0 ? nullptr : XB, a.out, nullptr, last ? nullptr : XB, YH, ada_l, 2048, a.in[7] + l * DM, YH, ada_l, 3072, 4096, a.in[8] + l * DM, Mo, bid, G);
        GSYNC();
        { pg8::Gemm g{(const pg8::bf16_t*)YH, (const pg8::bf16_t*)(wl + WO_1), Mo, DFF, DM}; pg8::StaticOrder S; S.init(Mo, DFF, G, bid);
          pg8::EpiBf16<1> E{(pg8::bf16_t*)U, DFF};
          pg8::gemm_phase<pg8::EpiBf16<1>, pg8::StaticOrder, true, true>((PG8_LAS unsigned char*)lds, g, S, E); }
        GSYNC();
        { pg8::Gemm g{(const pg8::bf16_t*)U, (const pg8::bf16_t*)(wl + WO_2), Mo, DM, DFF}; pg8::RevOrder S; S.init(Mo, DM, G, bid);
          pg8::EpiBf16<0> E{(pg8::bf16_t*)YH, DM};
          pg8::gemm_phase<pg8::EpiBf16<0>, pg8::RevOrder, true, true>((PG8_LAS unsigned char*)lds, g, S, E); }
        GSYNC();
        ew_phase(a.out, nullptr, last ? nullptr : XB, a.out, nullptr, last ? nullptr : XB, YH, ada_l, 5120, a.in[9] + l * DM, last ? nullptr : YH, ada_l + 33 * 6144, 0, 1024, a.in[6] + (last ? 0 : (l + 1) * DM), Mo, bid, G);
        if (!last) GSYNC();
    }
}

extern "C" void kernel_launch(void* const* d_in, const int* in_sizes, int n_in, void* d_out, int out_size, void* d_ws, size_t ws_size, hipStream_t stream) {
    static int grid = 0;
    if (grid == 0) {
        if (n_in != 29 || out_size != TL * DM || ws_size < WS_END) { fprintf(stderr, "kernel_launch: unexpected shapes (n_in %d out %d ws %zu)\n", n_in, out_size, ws_size); grid = -1; return; }
        int dev = 0, cus = 0, per_cu = 0;
        hipGetDevice(&dev); hipDeviceGetAttribute(&cus, hipDeviceAttributeMultiprocessorCount, dev);
        if (hipFuncSetAttribute((const void*)mega_fwd, hipFuncAttributeMaxDynamicSharedMemorySize, LDS_BYTES) != hipSuccess) { fprintf(stderr, "kernel_launch: hipFuncSetAttribute failed\n"); grid = -1; return; }
        if (hipOccupancyMaxActiveBlocksPerMultiprocessor(&per_cu, (const void*)mega_fwd, 512, LDS_BYTES) != hipSuccess || per_cu < 1) { fprintf(stderr, "kernel_launch: occupancy query failed (%d)\n", per_cu); per_cu = 1; }
        (void)hipGetLastError();
        grid = cus * per_cu;
    }
    if (grid < 0) return;
    Args a{};
    for (int i = 0; i < 29; ++i) a.in[i] = (const float*)d_in[i];
    a.out = (float*)d_out; a.ws = (unsigned char*)d_ws;
    void* args[] = {&a};
    hipError_t e = hipLaunchCooperativeKernel((const void*)mega_fwd, dim3(grid), dim3(512), args, LDS_BYTES, stream);
    if (e != hipSuccess) fprintf(stderr, "kernel_launch: cooperative launch failed: %s (grid %d)\n", hipGetErrorString(e), grid);
}
```
